# Optimizing an MI355X kernel written in HIP

```python
import jax, jax.numpy as jnp
from jax import lax
import numpy as np

D_MODEL = 4096
BATCH = 2
SEQ = 8192
DEPTH = 1
DEC_BATCH = 8
DEC_SEQ = 2048
PAST_LEN = 128

HG_HEADS = 32
HG_DK = D_MODEL // HG_HEADS
HG_DV = D_MODEL // HG_HEADS
D_A = HG_HEADS * HG_DV
CHUNK = 64
FN_GROUPS = 4
D_B = D_MODEL // 2
FN_CG = D_B // FN_GROUPS
N_IN = 5 * D_A + 2 * D_B + 2 * D_MODEL
EPS = 1e-6

kernel_name = "hgrn2_fnet_gated_parallel_encoder"


def _rmsnorm(x, g):
    xf = x.astype(jnp.float32)
    y = xf * lax.rsqrt(jnp.mean(xf * xf, axis=-1, keepdims=True) + EPS)
    return (y * g.astype(jnp.float32)).astype(x.dtype)


def _gla_chunkwise(q, k, v, log_f):
    B, L, H, DK = q.shape
    DV = v.shape[-1]
    n = L // CHUNK

    def to_chunks(t):
        return t.astype(jnp.float32).reshape(B, n, CHUNK, H, t.shape[-1]).transpose(1, 0, 3, 2, 4)

    qc, kc, vc, gc = to_chunks(q), to_chunks(k), to_chunks(v), to_chunks(log_f)
    tri = jnp.tril(jnp.ones((CHUNK, CHUNK), dtype=bool))[None, None, :, :, None]

    def step(S, inp):
        qi, ki, vi, gi = inp
        b = jnp.cumsum(gi, axis=2)
        diff = b[:, :, :, None, :] - b[:, :, None, :, :]
        decay = jnp.exp(jnp.where(tri, diff, -jnp.inf))
        scores = jnp.einsum('bhtk,bhsk,bhtsk->bhts', qi, ki, decay)
        o = (jnp.einsum('bhts,bhsv->bhtv', scores, vi)
             + jnp.einsum('bhtk,bhkv->bhtv', qi * jnp.exp(b), S))
        b_last = b[:, :, -1:, :]
        S_new = (jnp.exp(b_last[:, :, 0, :])[..., None] * S
                 + jnp.einsum('bhsk,bhsv->bhkv', ki * jnp.exp(b_last - b), vi))
        return S_new, o

    S0 = jnp.zeros((B, H, DK, DV), jnp.float32)
    _, oc = lax.scan(step, S0, (qc, kc, vc, gc))
    return oc.transpose(1, 0, 3, 2, 4).reshape(B, L, H, DV)


def _forget(zf, lb):
    zf = zf.astype(jnp.float32)
    f = lb + (1.0 - lb) * jax.nn.sigmoid(zf)
    return jnp.log(f), (1.0 - lb) * jax.nn.sigmoid(-zf)


def _layer(x, g_norm, w_in, lb_fwd, lb_bwd, g_head, w_a, w_b, w_o):
    B, L, _ = x.shape
    h = _rmsnorm(x, g_norm)
    z = h @ w_in
    splits = [D_A, 2 * D_A, 3 * D_A, 4 * D_A, 5 * D_A,
              5 * D_A + D_B, 5 * D_A + 2 * D_B, 5 * D_A + 2 * D_B + D_MODEL]
    q, zf_f, zf_b, i_v, gate_a, u_b, gate_b, m_a, m_b = jnp.split(z, splits, axis=-1)

    heads = lambda t: t.reshape(B, L, HG_HEADS, -1)
    qh = heads(jax.nn.silu(q.astype(jnp.float32)) * (HG_DK ** -0.5))
    vh = heads(i_v.astype(jnp.float32))
    logf_f, k_f = _forget(zf_f, lb_fwd)
    logf_b, k_b = _forget(zf_b, lb_bwd)
    o_f = _gla_chunkwise(qh, heads(k_f), vh, heads(logf_f))
    rev = lambda t: jnp.flip(t, axis=1)
    o_b = rev(_gla_chunkwise(rev(qh), rev(heads(k_b)), rev(vh), rev(heads(logf_b))))
    o = o_f + o_b
    o = o * lax.rsqrt(jnp.mean(o * o, axis=-1, keepdims=True) + EPS) * g_head.astype(jnp.float32)
    a_out = o.reshape(B, L, D_A).astype(x.dtype) * jax.nn.silu(gate_a)
    p_a = a_out @ w_a

    u = u_b.astype(jnp.float32).reshape(B, L, FN_GROUPS, FN_CG)
    fu = jnp.fft.fft2(u, axes=(1, 3), norm="ortho").real.reshape(B, L, D_B)
    b_out = fu.astype(x.dtype) * jax.nn.silu(gate_b)
    p_b = b_out @ w_b

    m = jax.nn.sigmoid(m_a) * p_a + jax.nn.sigmoid(m_b) * p_b
    return x + m @ w_o


def _trunk(x, norm_gain, w_in, lbs_fwd, lbs_bwd, head_norm_gain, w_branch_a, w_branch_b, w_out, final_norm_gain):
    for l in range(DEPTH):
        x = _layer(x, norm_gain[l], w_in[l], lbs_fwd[l], lbs_bwd[l], head_norm_gain[l],
                   w_branch_a[l], w_branch_b[l], w_out[l])
    return _rmsnorm(x, final_norm_gain)


def setup_inputs(seed: int = 0) -> dict:
    key = jax.random.key(seed)
    ks = jax.random.split(key, 12)
    f32 = jnp.float32
    return {
        "x_prompt": jax.random.normal(ks[0], (BATCH, SEQ, D_MODEL), f32),
        "x_sample": jax.random.normal(ks[1], (DEC_BATCH, DEC_SEQ, D_MODEL), f32),
        "norm_gain": 1.0 + 0.02 * jax.random.normal(ks[2], (DEPTH, D_MODEL), f32),
        "w_in": jax.random.normal(ks[3], (DEPTH, D_MODEL, N_IN), f32) * D_MODEL ** -0.5,
        "lower_bounds_fwd": 0.1 * jax.random.normal(ks[4], (DEPTH + 1, D_A), f32),
        "lower_bounds_bwd": 0.1 * jax.random.normal(ks[5], (DEPTH + 1, D_A), f32),
        "head_norm_gain": 1.0 + 0.02 * jax.random.normal(ks[6], (DEPTH, HG_HEADS, HG_DV), f32),
        "w_branch_a": jax.random.normal(ks[7], (DEPTH, D_A, D_MODEL), f32) * D_A ** -0.5,
        "w_branch_b": jax.random.normal(ks[8], (DEPTH, D_B, D_MODEL), f32) * D_B ** -0.5,
        "w_out": jax.random.normal(ks[9], (DEPTH, D_MODEL, D_MODEL), f32) * D_MODEL ** -0.5,
        "final_norm_gain": 1.0 + 0.02 * jax.random.normal(ks[10], (D_MODEL,), f32),
    }


def reference(x_prompt, x_sample, norm_gain, w_in, lower_bounds_fwd, lower_bounds_bwd,
              head_norm_gain, w_branch_a, w_branch_b, w_out, final_norm_gain):
    lbs_fwd = jnp.cumsum(jax.nn.softmax(lower_bounds_fwd.astype(jnp.float32), axis=0), axis=0)
    lbs_bwd = jnp.cumsum(jax.nn.softmax(lower_bounds_bwd.astype(jnp.float32), axis=0), axis=0)
    y_prompt = _trunk(x_prompt, norm_gain, w_in, lbs_fwd, lbs_bwd, head_norm_gain,
                      w_branch_a, w_branch_b, w_out, final_norm_gain)
    y_sample = _trunk(x_sample, norm_gain, w_in, lbs_fwd, lbs_bwd, head_norm_gain,
                      w_branch_a, w_branch_b, w_out, final_norm_gain)
    return (y_prompt, y_sample)
```

```cpp
#include <hip/hip_runtime.h>
#include <cstdio>
#include <cstdint>

#define LAS __attribute__((address_space(3)))
#define GAS __attribute__((address_space(1)))
typedef unsigned short bf16_t;
typedef short bf16x8 __attribute__((ext_vector_type(8)));
typedef short bf16x4 __attribute__((ext_vector_type(4)));
typedef float f32x2 __attribute__((ext_vector_type(2)));
typedef float f32x4 __attribute__((ext_vector_type(4)));
typedef float f32x16 __attribute__((ext_vector_type(16)));
typedef unsigned u32x2 __attribute__((ext_vector_type(2)));
typedef unsigned u32x4 __attribute__((ext_vector_type(4)));

#ifndef MK_N_LAUNCHES
#define MK_N_LAUNCHES 10
#endif
#ifndef GLA_NAIVE
#define GLA_NAIVE 1
#endif

constexpr int D = 4096, TOK = 32768, NPT = 16384, LP = 8192, LSQ = 2048, NH = 32, DH = 128, DB = 2048, CG = 512;
constexpr int C_U = 20480, C_MA = 24576, C_MB = 28672;
constexpr float EPS = 1e-6f;
constexpr int N_PHASES = 10;

constexpr size_t MiB = 1u << 20;
constexpr size_t WS_CTL = 0, CTL_ZERO_BYTES = 1 * MiB;
constexpr size_t WS_LBF = 1 * MiB, WS_LBB = 1 * MiB + 16384;
constexpr size_t WS_WIN = 2 * MiB, WS_WA = 258 * MiB, WS_WB = 290 * MiB, WS_WO = 306 * MiB, WS_H = 338 * MiB;
constexpr size_t WS_Q = 594 * MiB, WS_KF = 850 * MiB, WS_KB = 1106 * MiB, WS_V = 1362 * MiB, WS_GA = 1618 * MiB;
constexpr size_t WS_DFTC = 1874 * MiB, WS_DFTS2 = 1876 * MiB, WS_BOUT = 1892 * MiB, WS_END = 2020 * MiB;
constexpr size_t WS_PA = WS_Q, WS_U = WS_KF, WS_SGB = WS_KF + 128 * MiB, WS_M = WS_KF, WS_ABT = WS_KB, WS_DFTS8 = WS_V, WS_PB = WS_GA;
constexpr size_t ABT_SAMPLE_OFF = (size_t)2 * 2048 * 16384;
constexpr int CW_TMO = 0, CW_BAR = 4096;

constexpr int RING_BYTES = 131072;
constexpr int LDSCTL_OFF = RING_BYTES, MISC_OFF = LDSCTL_OFF + 320;
constexpr int LDS_BYTES = 147456;
constexpr int NWAVES = 8;

__device__ __forceinline__ unsigned cvt_pk_bf16(float lo, float hi) { unsigned r; asm("v_cvt_pk_bf16_f32 %0, %1, %2" : "=v"(r) : "v"(lo), "v"(hi)); return r; }
__device__ __forceinline__ float bf_lo(unsigned w) { return __uint_as_float(w << 16); }
__device__ __forceinline__ float bf_hi(unsigned w) { return __uint_as_float(w & 0xffff0000u); }
__device__ __forceinline__ float fexp(float x) { return __builtin_amdgcn_exp2f(x * 1.44269504089f); }
__device__ __forceinline__ float frcp(float x) { return __builtin_amdgcn_rcpf(x); }
__device__ __forceinline__ float fsig(float x) { return frcp(1.f + fexp(-x)); }
__device__ __forceinline__ float fsilu(float x) { return x * fsig(x); }
__device__ __forceinline__ float flog(float x) { return __builtin_amdgcn_logf(x) * 0.69314718056f; }
__device__ __forceinline__ float wave_sum(float v) {
#pragma unroll
    for (int o = 1; o < 64; o <<= 1) v += __shfl_xor(v, o);
    return v;
}
#define LDS_WAIT() asm volatile("s_waitcnt lgkmcnt(0)" ::: "memory")
#define VM_WAIT() asm volatile("s_waitcnt vmcnt(0)" ::: "memory")

namespace pg8 {
constexpr int BM = 256, BK = 64, HALF = 128, HTB = HALF * BK * 2, STAGE_BYTES = 8 * HTB, NXCD = 8, WGM = 8;
__host__ __device__ __forceinline__ int lds_byte(int r, int c) { const int st = (r >> 4) * 2 + (c >> 5), rr = r & 15, cc = c & 31, ob = rr * 64 + cc * 2; return st * 1024 + (ob ^ (((ob >> 9) & 1) << 5)); }
__host__ __device__ __forceinline__ void stage_rc(int b, int& R, int& C) { const int st = b / 1024, sb = b % 1024, swz = sb ^ (((sb >> 9) & 1) << 5); R = (st >> 1) * 16 + swz / 64; C = (st & 1) * 32 + (swz % 64) / 2; }
__host__ __device__ __forceinline__ int perm32(int rho) { const int n = rho >> 4, i = rho & 15; return 8 * (i >> 2) + 4 * n + (i & 3); }

struct Unit { int pm, pn; };
struct Ptrs { const char* a0; const char* a1; const char* b0; const char* b1; };

struct StaticOrder {
    int nM, nN, nwg, G, c;
    __host__ __device__ void init(int M, int N, int G_, int c_) { nM = M / BM; nN = N / BM; nwg = nM * nN; G = G_; c = c_; }
    __host__ __device__ bool next(int i, Unit& u) const {
        const long L = (long)i * G + c; if (L >= nwg) return false;
        int wgid = (int)L; { const int q = nwg / NXCD, r = nwg % NXCD, xcd = wgid % NXCD, off = wgid / NXCD; wgid = (xcd < r ? xcd * (q + 1) : r * (q + 1) + (xcd - r) * q) + off; }
        const int nig = WGM * nN, gid = wgid / nig, fm = gid * WGM, gsz = (nM - fm) < WGM ? (nM - fm) : WGM;
        u.pm = fm + ((wgid % nig) % gsz); u.pn = (wgid % nig) / gsz; return true;
    }
};

template <class P>
__device__ __forceinline__ void gemm_phase(LAS unsigned char* lds, const P& p) {
    const int tid = threadIdx.x, wid = __builtin_amdgcn_readfirstlane(tid >> 6), lane = tid & 63, wr = wid >> 2, wc = wid & 3, fr = lane & 15, fq = lane >> 4;
    const int nt = p.nt;
    unsigned voffA[2], voffB[2];
#pragma unroll
    for (int i = 0; i < 2; ++i) { int R, C; stage_rc(tid * 16 + i * 8192, R, C); const int Rb = P::PERM ? ((R & ~31) + perm32(R & 31)) : R;
        voffA[i] = (unsigned)(R * p.lda + C) * 2u; voffB[i] = (unsigned)(Rb * p.ldb + C) * 2u; }
    const size_t kstep = (size_t)(BK * 2);
    const unsigned ldsw = (unsigned)wid * 1024u;
    const int aoff = lds_byte(wr * 64 + fr, fq * 8), boff = lds_byte(wc * 32 + fr, fq * 8);
#define PG8_SA(b, h) (((b) * 2 + (h)) * HTB)
#define PG8_SB(b, h) ((4 + (b) * 2 + (h)) * HTB)
#define PG8_STAGE(bufoff, gbase, voff) do { _Pragma("unroll") for (int _i = 0; _i < 2; ++_i) \
        __builtin_amdgcn_global_load_lds((const unsigned*)((const char*)(gbase) + (voff)[_i]), (LAS unsigned*)(lds + (bufoff) + ldsw + _i * 8192), 16, 0, 0); } while (0)
#define PG8_LDA(dst, b, h) do { _Pragma("unroll") for (int m = 0; m < 4; ++m) _Pragma("unroll") for (int k = 0; k < 2; ++k) dst[m][k] = *(const LAS bf16x8*)(lds + PG8_SA(b, h) + aoff + m * 2048 + k * 1024); } while (0)
#define PG8_LDB(dst, b, h) do { _Pragma("unroll") for (int n = 0; n < 2; ++n) _Pragma("unroll") for (int k = 0; k < 2; ++k) dst[n][k] = *(const LAS bf16x8*)(lds + PG8_SB(b, h) + boff + n * 2048 + k * 1024); } while (0)
#define PG8_MMA(ai, bj, At, Bt) do { __builtin_amdgcn_s_setprio(1); _Pragma("unroll") for (int m = 0; m < 4; ++m) _Pragma("unroll") for (int n = 0; n < 2; ++n) _Pragma("unroll") for (int k = 0; k < 2; ++k) \
        acc[ai][bj][m][n] = __builtin_amdgcn_mfma_f32_16x16x32_bf16(Bt[n][k], At[m][k], acc[ai][bj][m][n], 0, 0, 0); __builtin_amdgcn_s_setprio(0); } while (0)
#define PG8_WAIT_V(n) asm volatile("s_waitcnt vmcnt(" #n ")" ::: "memory")
#define PG8_WAIT_L(n) asm volatile("s_waitcnt lgkmcnt(" #n ")" ::: "memory")
#define PG8_BAR __builtin_amdgcn_s_barrier()
#define PG8_SCHED __builtin_amdgcn_sched_barrier(0)
    Unit cur, nxt; int ui = 0;
    if (!p.next(0, cur)) return;
    f32x4 acc[2][2][4][2];
#pragma unroll
    for (int a = 0; a < 2; ++a)
#pragma unroll
        for (int b = 0; b < 2; ++b)
#pragma unroll
            for (int m = 0; m < 4; ++m)
#pragma unroll
                for (int n = 0; n < 2; ++n) acc[a][b][m][n] = (f32x4){0.f, 0.f, 0.f, 0.f};
    bf16x8 At[4][2], B0[2][2], B1[2][2];
    Ptrs cq; p.ptrs(cur, cq);
    PG8_STAGE(PG8_SB(0, 0), cq.b0, voffB); PG8_STAGE(PG8_SB(0, 1), cq.b1, voffB); PG8_STAGE(PG8_SA(0, 0), cq.a0, voffA); PG8_STAGE(PG8_SA(0, 1), cq.a1, voffA);
    if (wr == 1) PG8_BAR;
    PG8_WAIT_V(2); PG8_BAR;
    PG8_STAGE(PG8_SB(1, 0), cq.b0 + kstep, voffB); PG8_STAGE(PG8_SA(1, 0), cq.a0 + kstep, voffA); PG8_STAGE(PG8_SB(1, 1), cq.b1 + kstep, voffB);
    PG8_WAIT_V(6); PG8_BAR;
    for (;;) {
        const bool has_next = p.next(ui + 1, nxt);
        Ptrs nq = cq; if (has_next) p.ptrs(nxt, nq);
        for (int t = 0; t < nt; t += 2) {
            const bool last = (t == nt - 2);
            const size_t o1 = (size_t)(t + 1) * kstep, o2 = (size_t)(t + 2) * kstep;
            const char* a1_1 = cq.a1 + o1;
            const char* a2_0 = last ? nq.a0 : cq.a0 + o2; const char* a2_1 = last ? nq.a1 : cq.a1 + o2;
            const char* b2_0 = last ? nq.b0 : cq.b0 + o2; const char* b2_1 = last ? nq.b1 : cq.b1 + o2;
            PG8_LDB(B0, 0, 0); PG8_LDB(B1, 0, 1); PG8_SCHED; PG8_LDA(At, 0, 0); PG8_STAGE(PG8_SA(1, 1), a1_1, voffA);
            PG8_WAIT_V(8); PG8_WAIT_L(0); PG8_BAR; PG8_MMA(0, 0, At, B0); PG8_MMA(0, 1, At, B1); PG8_BAR; PG8_SCHED;
            PG8_LDA(At, 0, 1); PG8_STAGE(PG8_SB(0, 0), b2_0, voffB); PG8_STAGE(PG8_SB(0, 1), b2_1, voffB); PG8_STAGE(PG8_SA(0, 0), a2_0, voffA);
            PG8_WAIT_V(8); PG8_WAIT_L(0); PG8_BAR; PG8_MMA(1, 0, At, B0); PG8_MMA(1, 1, At, B1); PG8_BAR; PG8_SCHED;
            PG8_LDB(B0, 1, 0); PG8_LDB(B1, 1, 1); PG8_SCHED; PG8_LDA(At, 1, 0); PG8_STAGE(PG8_SA(0, 1), a2_1, voffA);
            PG8_WAIT_V(8); PG8_WAIT_L(0); PG8_BAR; PG8_MMA(0, 0, At, B0); PG8_MMA(0, 1, At, B1); PG8_BAR; PG8_SCHED;
            PG8_LDA(At, 1, 1); PG8_STAGE(PG8_SB(1, 0), b2_0 + kstep, voffB); PG8_STAGE(PG8_SB(1, 1), b2_1 + kstep, voffB); PG8_STAGE(PG8_SA(1, 0), a2_0 + kstep, voffA);
            PG8_WAIT_V(8); PG8_WAIT_L(0); PG8_BAR; PG8_MMA(1, 0, At, B0); PG8_MMA(1, 1, At, B1); PG8_BAR; PG8_SCHED;
        }
        if (wr == 0) PG8_BAR;
        p.epi(acc, cur, wr, wc, fr, fq);
        if (!has_next) break;
#pragma unroll
        for (int a = 0; a < 2; ++a)
#pragma unroll
            for (int b = 0; b < 2; ++b)
#pragma unroll
                for (int m = 0; m < 4; ++m)
#pragma unroll
                    for (int n = 0; n < 2; ++n) acc[a][b][m][n] = (f32x4){0.f, 0.f, 0.f, 0.f};
        cur = nxt; cq = nq; ++ui;
        if (wr == 1) PG8_BAR;
    }
    PG8_WAIT_V(0);
    PG8_BAR;
#undef PG8_SA
#undef PG8_SB
#undef PG8_STAGE
#undef PG8_LDA
#undef PG8_LDB
#undef PG8_MMA
#undef PG8_WAIT_V
#undef PG8_WAIT_L
#undef PG8_BAR
#undef PG8_SCHED
}
}

#define XB_TMO      128
#define XB_XCNT(j)  (256  + 64 * (j))
#define XB_XSUB(j)  (1280 + 64 * (j))
#define XB_XGEN(j)  (2304 + 64 * (j))
#define XB_TOP      3328
#define XB_TOPGEN   3392
#define XCD_BAR_WORDS 3456
#define XB_SPIN_CAP (1u << 18)
__device__ __forceinline__ unsigned xb_ld(unsigned* p)              { return __hip_atomic_load(p, __ATOMIC_RELAXED, __HIP_MEMORY_SCOPE_AGENT); }
__device__ __forceinline__ unsigned xb_add(unsigned* p, unsigned v) { return __hip_atomic_fetch_add(p, v, __ATOMIC_RELAXED, __HIP_MEMORY_SCOPE_AGENT); }
__device__ __forceinline__ unsigned xb_xcc_id() { return (unsigned)__builtin_amdgcn_s_getreg((3 << 11) | 20) & 0xFu; }
#define XB_SPIN(cond, bar) do { unsigned _sp = 0; while (cond) { __builtin_amdgcn_s_sleep(1); \
    if ((++_sp & 255u) == 0u) { if (xb_ld(&(bar)[XB_TMO])) break; if (_sp > XB_SPIN_CAP) { atomicAdd(&(bar)[XB_TMO], 1u); break; } } } } while (0)
struct XcdBarrier { unsigned* bar; unsigned x; volatile LAS unsigned* st; };
__device__ __forceinline__ XcdBarrier xcd_barrier_post(unsigned* bar, volatile LAS unsigned* st) {
    XcdBarrier b; b.bar = bar; b.x = xb_xcc_id(); b.st = st;
    if (threadIdx.x == 0) (void)xb_add(&bar[XB_XCNT(b.x)], 1u);
    return b;
}
__device__ __forceinline__ void xcd_barrier_complete(unsigned* bar, unsigned x, unsigned& nloc, unsigned& nx) {
    const unsigned G = gridDim.x * gridDim.y * gridDim.z;
    unsigned sum, cnt, mine, sp = 0u;
    for (;;) {
        sum = 0u; cnt = 0u; mine = 0u;
#pragma unroll
        for (unsigned j = 0; j < 16; ++j) { const unsigned c = xb_ld(&bar[XB_XCNT(j)]); sum += c; cnt += (c > 0u) ? 1u : 0u; mine = (j == x) ? c : mine; }
        if (sum == G) break;
        __builtin_amdgcn_s_sleep(1);
        if ((++sp & 255u) == 0u) { if (xb_ld(&bar[XB_TMO])) break; if (sp > XB_SPIN_CAP) { atomicAdd(&bar[XB_TMO], 1u); break; } }
    }
    nloc = mine > 0u ? mine : 1u; nx = cnt > 0u ? cnt : 1u;
}
__device__ __forceinline__ void xcd_barrier(const XcdBarrier& b) {
    asm volatile("s_waitcnt vmcnt(0)" ::: "memory");
    __syncthreads();
    if (threadIdx.x == 0) {
        unsigned* bar = b.bar;
        __builtin_amdgcn_s_waitcnt(0);
        unsigned nloc = b.st[0], nx = b.st[1];
        if (nloc == 0u) { xcd_barrier_complete(bar, b.x, nloc, nx); b.st[0] = nloc; b.st[1] = nx; }
        const unsigned old = xb_add(&bar[XB_XSUB(b.x)], 1u);
        const unsigned gen = old / nloc;
        if (old + 1u == (gen + 1u) * nloc) {
            __builtin_amdgcn_fence(__ATOMIC_RELEASE, "agent");
            asm volatile("s_waitcnt vmcnt(0)" ::: "memory");
            const unsigned og = xb_add(&bar[XB_TOP], 1u);
            const unsigned tg = og / nx;
            if (og + 1u == (tg + 1u) * nx) xb_add(&bar[XB_TOPGEN], 1u);
            else XB_SPIN(xb_ld(&bar[XB_TOPGEN]) == tg, bar);
            __builtin_amdgcn_fence(__ATOMIC_ACQUIRE, "agent");
            xb_add(&bar[XB_XGEN(b.x)], 1u);
            asm volatile("s_waitcnt vmcnt(0)" ::: "memory");
        } else {
            XB_SPIN(xb_ld(&bar[XB_XGEN(b.x)]) == gen, bar);
            __builtin_amdgcn_fence(__ATOMIC_ACQUIRE, "agent");
            asm volatile("s_waitcnt vmcnt(0)" ::: "memory");
        }
    }
    __syncthreads();
}

struct Ctx { unsigned char* ws; const float* xp; const float* xs; float* out; int G, c; };

template <class F> __device__ __forceinline__ void epi_store_bf16(const f32x4 (&acc)[2][2][4][2], bf16_t* tile  , size_t ldc, const F& f) {
#pragma unroll
    for (int ai = 0; ai < 2; ++ai)
#pragma unroll
        for (int m = 0; m < 4; ++m) { bf16_t* rowp = tile + (size_t)(ai * 128 + m * 16) * ldc;
#pragma unroll
            for (int bj = 0; bj < 2; ++bj) { f32x4 v0 = acc[ai][bj][m][0], v1 = acc[ai][bj][m][1];
                f(v0, v1, bj, ai * 128 + m * 16);
                u32x4 w; w.x = cvt_pk_bf16(v0[0], v0[1]); w.y = cvt_pk_bf16(v0[2], v0[3]); w.z = cvt_pk_bf16(v1[0], v1[1]); w.w = cvt_pk_bf16(v1[2], v1[3]);
                *(u32x4*)(rowp + bj * 128) = w; } }
}
struct FIdent { __device__ __forceinline__ void operator()(f32x4&, f32x4&, int, int) const {} };
struct FSilu { float s; __device__ __forceinline__ void operator()(f32x4& a, f32x4& b, int, int) const {
#pragma unroll
    for (int e = 0; e < 4; ++e) { a[e] = fsilu(a[e]) * s; b[e] = fsilu(b[e]) * s; } } };
struct FLogF { f32x4 lb[2][2]; __device__ __forceinline__ void operator()(f32x4& a, f32x4& b, int bj, int) const {
#pragma unroll
    for (int e = 0; e < 4; ++e) { const float l0 = lb[bj][0][e], l1 = lb[bj][1][e];
        a[e] = flog(l0 + (1.f - l0) * fsig(a[e])); b[e] = flog(l1 + (1.f - l1) * fsig(b[e])); } } };

struct ProbG1a {
    static constexpr bool PERM = true;
    pg8::StaticOrder S; int lda, ldb, nt; unsigned char* ws;
    __device__ __forceinline__ void init(const Ctx& c) { S.init(TOK, 20480, c.G, c.c); lda = D; ldb = D; nt = D / 64; ws = c.ws; }
    __device__ __forceinline__ bool next(int i, pg8::Unit& u) const { return S.next(i, u); }
    __device__ __forceinline__ void ptrs(const pg8::Unit& u, pg8::Ptrs& q) const {
        q.a0 = (const char*)(ws + WS_H) + (size_t)u.pm * 256 * D * 2; q.a1 = q.a0 + (size_t)128 * D * 2;
        q.b0 = (const char*)(ws + WS_WIN) + (size_t)u.pn * 256 * D * 2; q.b1 = q.b0 + (size_t)128 * D * 2; }
    __device__ __forceinline__ void epi(const f32x4 (&acc)[2][2][4][2], const pg8::Unit& u, int wr, int wc, int fr, int fq) const {
        const int seg = u.pn >> 4, colt = (u.pn & 15) * 256 + wc * 32 + 8 * fq, row0 = u.pm * 256 + wr * 64 + fr;
        bf16_t* tile = (bf16_t*)(ws + WS_Q + (size_t)seg * 256 * MiB) + (size_t)row0 * D + colt;
        if (seg == 0) { FSilu f{0.08838834764831845f}; epi_store_bf16(acc, tile, D, f); }
        else if (seg == 1 || seg == 2) { const float* lb = (const float*)(ws + (seg == 1 ? WS_LBF : WS_LBB)) + colt; FLogF f;
#pragma unroll
            for (int bj = 0; bj < 2; ++bj)
#pragma unroll
                for (int n = 0; n < 2; ++n) f.lb[bj][n] = *(const f32x4*)(lb + bj * 128 + 4 * n);
            epi_store_bf16(acc, tile, D, f); }
        else if (seg == 3) { FIdent f; epi_store_bf16(acc, tile, D, f); }
        else { FSilu f{1.f}; epi_store_bf16(acc, tile, D, f); }
    }
};
struct ProbPlain {
    static constexpr bool PERM = true;
    pg8::StaticOrder S; int lda, ldb, nt; const char* A; const char* B; bf16_t* C; int ldc;
    __device__ __forceinline__ void init(const Ctx& c, const void* A_, const void* B_, void* C_, int N, int K) { S.init(TOK, N, c.G, c.c); lda = K; ldb = K; nt = K / 64; A = (const char*)A_; B = (const char*)B_; C = (bf16_t*)C_; ldc = N; }
    __device__ __forceinline__ bool next(int i, pg8::Unit& u) const { return S.next(i, u); }
    __device__ __forceinline__ void ptrs(const pg8::Unit& u, pg8::Ptrs& q) const {
        q.a0 = A + (size_t)u.pm * 256 * lda * 2; q.a1 = q.a0 + (size_t)128 * lda * 2; q.b0 = B + (size_t)u.pn * 256 * ldb * 2; q.b1 = q.b0 + (size_t)128 * ldb * 2; }
    __device__ __forceinline__ void epi(const f32x4 (&acc)[2][2][4][2], const pg8::Unit& u, int wr, int wc, int fr, int fq) const {
        bf16_t* tile = C + (size_t)(u.pm * 256 + wr * 64 + fr) * ldc + u.pn * 256 + wc * 32 + 8 * fq; FIdent f; epi_store_bf16(acc, tile, ldc, f); }
};
struct ProbG1b {
    static constexpr bool PERM = true;
    pg8::StaticOrder S; int lda, ldb, nt; unsigned char* ws;
    __device__ __forceinline__ void init(const Ctx& c) { S.init(TOK, 4096, c.G, c.c); lda = D; ldb = D; nt = D / 64; ws = c.ws; }
    __device__ __forceinline__ bool next(int i, pg8::Unit& u) const { return S.next(i, u); }
    __device__ __forceinline__ void ptrs(const pg8::Unit& u, pg8::Ptrs& q) const {
        q.a0 = (const char*)(ws + WS_H) + (size_t)u.pm * 256 * D * 2; q.a1 = q.a0 + (size_t)128 * D * 2;
        q.b0 = (const char*)(ws + WS_WIN) + (size_t)(C_U + u.pn * 256) * D * 2; q.b1 = q.b0 + (size_t)128 * D * 2; }
    __device__ __forceinline__ void epi(const f32x4 (&acc)[2][2][4][2], const pg8::Unit& u, int wr, int wc, int fr, int fq) const {
        const int seg = u.pn >> 3, colt = (u.pn & 7) * 256 + wc * 32 + 8 * fq, row0 = u.pm * 256 + wr * 64 + fr;
        bf16_t* tile = (bf16_t*)(ws + (seg ? WS_SGB : WS_U)) + (size_t)row0 * DB + colt;
        if (seg == 0) { FIdent f; epi_store_bf16(acc, tile, DB, f); } else { FSilu f{1.f}; epi_store_bf16(acc, tile, DB, f); }
    }
};
struct ProbDft1 {
    static constexpr bool PERM = true;
    pg8::StaticOrder S; int lda, ldb, nt; unsigned char* ws;
    __device__ __forceinline__ void init(const Ctx& c) { S.init(4096, TOK, c.G, c.c); lda = CG; ldb = DB; nt = CG / 64; ws = c.ws; }
    __device__ __forceinline__ bool next(int i, pg8::Unit& u) const { return S.next(i, u); }
    __device__ __forceinline__ void ptrs(const pg8::Unit& u, pg8::Ptrs& q) const {
        const int g = u.pm >> 2, pmr = u.pm & 3;
        q.a0 = (const char*)(ws + WS_DFTC) + (size_t)pmr * 256 * CG * 2; q.a1 = q.a0 + (size_t)128 * CG * 2;
        q.b0 = (const char*)(ws + WS_U) + ((size_t)u.pn * 256 * DB + (size_t)g * CG) * 2; q.b1 = q.b0 + (size_t)128 * DB * 2; }
    __device__ __forceinline__ void epi(const f32x4 (&acc)[2][2][4][2], const pg8::Unit& u, int wr, int wc, int fr, int fq) const {
        const int g = u.pm >> 2, pmr = u.pm & 3, part = pmr >> 1, j0 = (pmr & 1) * 256 + wr * 64 + fr;
        const int tt = u.pn; size_t base; int L, l0;
        if (tt < 64) { L = LP; base = (size_t)(tt >> 5) * 2048 * (2 * LP); l0 = (tt & 31) * 256; }
        else { const int ts = tt - 64; L = LSQ; base = ABT_SAMPLE_OFF + (size_t)(ts >> 3) * 2048 * (2 * LSQ); l0 = (ts & 7) * 256; }
        bf16_t* tile = (bf16_t*)(ws + WS_ABT) + base + (size_t)(g * CG + j0) * (2 * L) + (size_t)part * L + l0 + wc * 32 + 8 * fq;
        FIdent f; epi_store_bf16(acc, tile, (size_t)2 * L, f);
    }
};
struct FMulG { const bf16_t* g; __device__ __forceinline__ void operator()(f32x4& a, f32x4& b, int bj, int roff) const {
    const u32x4 w = *(const u32x4*)(g + (size_t)roff * DB + bj * 128);
    a[0] *= bf_lo(w.x); a[1] *= bf_hi(w.x); a[2] *= bf_lo(w.y); a[3] *= bf_hi(w.y); b[0] *= bf_lo(w.z); b[1] *= bf_hi(w.z); b[2] *= bf_lo(w.w); b[3] *= bf_hi(w.w); } };
struct ProbDft2 {
    static constexpr bool PERM = true;
    pg8::StaticOrder S; int lda, ldb, nt; unsigned char* ws; int L, lshift; size_t abt_off, dfts_off; int tok0;
    __device__ __forceinline__ void init(const Ctx& c, int sample) { S.init(16384, DB, c.G, c.c); ws = c.ws;
        if (!sample) { L = LP; lshift = 5; abt_off = 0; dfts_off = WS_DFTS8; tok0 = 0; } else { L = LSQ; lshift = 3; abt_off = ABT_SAMPLE_OFF; dfts_off = WS_DFTS2; tok0 = NPT; }
        lda = 2 * L; ldb = 2 * L; nt = 2 * L / 64; }
    __device__ __forceinline__ bool next(int i, pg8::Unit& u) const { return S.next(i, u); }
    __device__ __forceinline__ void ptrs(const pg8::Unit& u, pg8::Ptrs& q) const {
        const int b = u.pm >> lshift, pml = u.pm & ((1 << lshift) - 1);
        q.a0 = (const char*)(ws + dfts_off) + (size_t)pml * 256 * (2 * L) * 2; q.a1 = q.a0 + (size_t)128 * (2 * L) * 2;
        q.b0 = (const char*)(ws + WS_ABT) + (abt_off + (size_t)b * 2048 * (2 * L) + (size_t)u.pn * 256 * (2 * L)) * 2; q.b1 = q.b0 + (size_t)128 * (2 * L) * 2; }
    __device__ __forceinline__ void epi(const f32x4 (&acc)[2][2][4][2], const pg8::Unit& u, int wr, int wc, int fr, int fq) const {
        const size_t off = (size_t)(tok0 + u.pm * 256 + wr * 64 + fr) * DB + u.pn * 256 + wc * 32 + 8 * fq;
        FMulG f{(const bf16_t*)(ws + WS_SGB) + off}; epi_store_bf16(acc, (bf16_t*)(ws + WS_BOUT) + off, DB, f);
    }
};
struct ProbMerge {
    static constexpr bool PERM = true;
    pg8::StaticOrder S; int lda, ldb, nt; unsigned char* ws;
    __device__ __forceinline__ void init(const Ctx& c) { S.init(TOK, 8192, c.G, c.c); lda = D; ldb = D; nt = D / 64; ws = c.ws; }
    __device__ __forceinline__ bool next(int i, pg8::Unit& u) const { return S.next(i, u); }
    __device__ __forceinline__ void ptrs(const pg8::Unit& u, pg8::Ptrs& q) const {
        q.a0 = (const char*)(ws + WS_H) + (size_t)u.pm * 256 * D * 2; q.a1 = q.a0 + (size_t)128 * D * 2;
        q.b0 = (const char*)(ws + WS_WIN) + (size_t)(C_MA + u.pn * 128) * D * 2; q.b1 = (const char*)(ws + WS_WIN) + (size_t)(C_MB + u.pn * 128) * D * 2; }
    __device__ __forceinline__ void epi(const f32x4 (&acc)[2][2][4][2], const pg8::Unit& u, int wr, int wc, int fr, int fq) const {
        const size_t off0 = (size_t)(u.pm * 256 + wr * 64 + fr) * D + u.pn * 128 + wc * 32 + 8 * fq;
        const bf16_t* pa = (const bf16_t*)(ws + WS_PA) + off0; const bf16_t* pb = (const bf16_t*)(ws + WS_PB) + off0; bf16_t* mo = (bf16_t*)(ws + WS_M) + off0;
#pragma unroll
        for (int ai = 0; ai < 2; ++ai)
#pragma unroll
            for (int m = 0; m < 4; ++m) { const size_t ro = (size_t)(ai * 128 + m * 16) * D;
                const u32x4 wa = *(const u32x4*)(pa + ro), wb = *(const u32x4*)(pb + ro);
                const f32x4 a0 = acc[ai][0][m][0], a1 = acc[ai][0][m][1], b0 = acc[ai][1][m][0], b1 = acc[ai][1][m][1];
                float r[8];
                r[0] = fsig(a0[0]) * bf_lo(wa.x) + fsig(b0[0]) * bf_lo(wb.x); r[1] = fsig(a0[1]) * bf_hi(wa.x) + fsig(b0[1]) * bf_hi(wb.x);
                r[2] = fsig(a0[2]) * bf_lo(wa.y) + fsig(b0[2]) * bf_lo(wb.y); r[3] = fsig(a0[3]) * bf_hi(wa.y) + fsig(b0[3]) * bf_hi(wb.y);
                r[4] = fsig(a1[0]) * bf_lo(wa.z) + fsig(b1[0]) * bf_lo(wb.z); r[5] = fsig(a1[1]) * bf_hi(wa.z) + fsig(b1[1]) * bf_hi(wb.z);
                r[6] = fsig(a1[2]) * bf_lo(wa.w) + fsig(b1[2]) * bf_lo(wb.w); r[7] = fsig(a1[3]) * bf_hi(wa.w) + fsig(b1[3]) * bf_hi(wb.w);
                u32x4 w; w.x = cvt_pk_bf16(r[0], r[1]); w.y = cvt_pk_bf16(r[2], r[3]); w.z = cvt_pk_bf16(r[4], r[5]); w.w = cvt_pk_bf16(r[6], r[7]);
                *(u32x4*)(mo + ro) = w; }
    }
};
struct ProbOut {
    static constexpr bool PERM = false;
    pg8::StaticOrder S; int lda, ldb, nt; unsigned char* ws; const float* xp; const float* xs; float* out;
    __device__ __forceinline__ void init(const Ctx& c) { S.init(TOK, D, c.G, c.c); lda = D; ldb = D; nt = D / 64; ws = c.ws; xp = c.xp; xs = c.xs; out = c.out; }
    __device__ __forceinline__ bool next(int i, pg8::Unit& u) const { return S.next(i, u); }
    __device__ __forceinline__ void ptrs(const pg8::Unit& u, pg8::Ptrs& q) const {
        q.a0 = (const char*)(ws + WS_M) + (size_t)u.pm * 256 * D * 2; q.a1 = q.a0 + (size_t)128 * D * 2;
        q.b0 = (const char*)(ws + WS_WO) + (size_t)u.pn * 256 * D * 2; q.b1 = q.b0 + (size_t)128 * D * 2; }
    __device__ __forceinline__ void epi(const f32x4 (&acc)[2][2][4][2], const pg8::Unit& u, int wr, int wc, int fr, int fq) const {
        const int row0 = u.pm * 256 + wr * 64 + fr, col0 = u.pn * 256 + wc * 32 + 4 * fq;
        const float* xb = (u.pm < 64) ? xp + (size_t)row0 * D : xs + (size_t)(row0 - NPT) * D;
        float* ob = out + (size_t)row0 * D;
#pragma unroll
        for (int ai = 0; ai < 2; ++ai)
#pragma unroll
            for (int m = 0; m < 4; ++m) { const size_t ro = (size_t)(ai * 128 + m * 16) * D + col0;
#pragma unroll
                for (int bj = 0; bj < 2; ++bj)
#pragma unroll
                    for (int n = 0; n < 2; ++n) { const f32x4 xv = *(const f32x4*)(xb + ro + bj * 128 + n * 16); *(f32x4*)(ob + ro + bj * 128 + n * 16) = acc[ai][bj][m][n] + xv; } }
    }
};

__device__ __forceinline__ unsigned f2bf(float f) { unsigned u = __builtin_bit_cast(unsigned, f); return (u + 0x7fffu + ((u >> 16) & 1u)) >> 16; }
__device__ __forceinline__ unsigned pk2(float lo, float hi) { return f2bf(lo) | (f2bf(hi) << 16); }
__device__ __forceinline__ void p0_transpose_item(const float* W, int K, int N, bf16_t* WT, LAS float* scr, int item, int lane) {
    const int nblk = N / 32, kb = item / nblk, nb = item % nblk, k0 = 64 * kb, n0 = 32 * nb;
#pragma unroll 8
    for (int i = 0; i < 32; ++i) { const int kk = 2 * i + (lane >> 5); scr[kk * 33 + (lane & 31)] = W[(size_t)(k0 + kk) * N + n0 + (lane & 31)]; }
    LDS_WAIT(); asm volatile("" ::: "memory");
    const int c = lane & 7;
#pragma unroll
    for (int j = 0; j < 4; ++j) { const int n = (lane >> 3) + 8 * j; const LAS float* s = scr + (8 * c) * 33 + n;
        u32x4 o; o.x = pk2(s[0 * 33], s[1 * 33]); o.y = pk2(s[2 * 33], s[3 * 33]); o.z = pk2(s[4 * 33], s[5 * 33]); o.w = pk2(s[6 * 33], s[7 * 33]);
        *(u32x4*)(WT + (size_t)(n0 + n) * K + k0 + 8 * c) = o; }
    LDS_WAIT(); asm volatile("" ::: "memory");
}
template <bool OUT_BF16> __device__ __forceinline__ void rms_row(const float* xrow, const float* g, void* orow, int lane) {
    const f32x4* xr = (const f32x4*)xrow + lane;
    f32x4 v[16]; float s = 0.f;
#pragma unroll
    for (int j = 0; j < 16; ++j) { v[j] = xr[64 * j]; s += (v[j].x * v[j].x + v[j].y * v[j].y) + (v[j].z * v[j].z + v[j].w * v[j].w); }
    const float rstd = 1.0f / sqrtf(wave_sum(s) * (1.f / D) + EPS);
    const f32x4* gr = (const f32x4*)g + lane;
#pragma unroll
    for (int j = 0; j < 16; ++j) { const f32x4 gv = gr[64 * j]; const f32x4 y = v[j] * rstd * gv;
        if (OUT_BF16) { u32x2 w; w.x = cvt_pk_bf16(y.x, y.y); w.y = cvt_pk_bf16(y.z, y.w); ((u32x2*)orow)[lane + 64 * j] = w; }
        else ((f32x4*)orow)[lane + 64 * j] = y; }
}

struct Args { const float* in[11]; float* out; unsigned char* ws; int ph_lo, ph_hi; };

__device__ __forceinline__ void gla_pair_info(int p, int& tok0, int& L, int& h) { h = p & 31; if (p < 64) { tok0 = (p >> 5) * LP; L = LP; } else { tok0 = NPT + ((p - 64) >> 5) * LSQ; L = LSQ; } }

#if GLA_NAIVE
__device__ __forceinline__ void gla_pair_naive(LAS unsigned char* lds, unsigned char* ws, const float* ghead, int p) {
    const int tid = threadIdx.x, lane = tid & 63, wave = tid >> 6;
    int tok0, L, h; gla_pair_info(p, tok0, L, h);
    const bf16_t* Q = (const bf16_t*)(ws + WS_Q); bf16_t* KF = (bf16_t*)(ws + WS_KF); const bf16_t* KB = (const bf16_t*)(ws + WS_KB);
    const bf16_t* V = (const bf16_t*)(ws + WS_V); bf16_t* GA = (bf16_t*)(ws + WS_GA);
    LAS float* Lq = (LAS float*)lds; LAS float* Lf = Lq + 16 * 128; LAS float* Lk = Lf + 16 * 128; LAS float* Lv = Lk + 16 * 128; LAS float* Lo = Lv + 16 * 128;
    const int v = tid & 127, kq = tid >> 7;
    for (int pass = 0; pass < 2; ++pass) {
        float S[32];
#pragma unroll
        for (int i = 0; i < 32; ++i) S[i] = 0.f;
        const bf16_t* F = pass ? KB : (const bf16_t*)KF;
        for (int blk = 0; blk < L / 16; ++blk) {
            { const int i = tid >> 5, c4 = (tid & 31) * 4; const int tau = blk * 16 + i; const int t = tok0 + (pass ? (L - 1 - tau) : tau);
              const size_t off = (size_t)t * D + h * DH + c4;
              const u32x2 wq = *(const u32x2*)(Q + off), wf = *(const u32x2*)(F + off), wv = *(const u32x2*)(V + off);
              const float lf0 = bf_lo(wf.x), lf1 = bf_hi(wf.x), lf2 = bf_lo(wf.y), lf3 = bf_hi(wf.y);
              const float f0 = fexp(lf0), f1 = fexp(lf1), f2 = fexp(lf2), f3 = fexp(lf3);
              *(LAS f32x4*)(Lq + i * 128 + c4) = (f32x4){bf_lo(wq.x), bf_hi(wq.x), bf_lo(wq.y), bf_hi(wq.y)};
              *(LAS f32x4*)(Lf + i * 128 + c4) = (f32x4){f0, f1, f2, f3};
              *(LAS f32x4*)(Lk + i * 128 + c4) = (f32x4){1.f - f0, 1.f - f1, 1.f - f2, 1.f - f3};
              *(LAS f32x4*)(Lv + i * 128 + c4) = (f32x4){bf_lo(wv.x), bf_hi(wv.x), bf_lo(wv.y), bf_hi(wv.y)}; }
            __syncthreads();
            for (int i = 0; i < 16; ++i) {
                const float vv = Lv[i * 128 + v]; float op = 0.f;
#pragma unroll
                for (int k4 = 0; k4 < 8; ++k4) {
                    const f32x4 f = *(const LAS f32x4*)(Lf + i * 128 + kq * 32 + k4 * 4), kx = *(const LAS f32x4*)(Lk + i * 128 + kq * 32 + k4 * 4), qx = *(const LAS f32x4*)(Lq + i * 128 + kq * 32 + k4 * 4);
#pragma unroll
                    for (int e = 0; e < 4; ++e) { S[k4 * 4 + e] = f[e] * S[k4 * 4 + e] + kx[e] * vv; op += S[k4 * 4 + e] * qx[e]; }
                }
                Lo[(i * 4 + kq) * 128 + v] = op;
            }
            __syncthreads();
#pragma unroll
            for (int j = 0; j < 2; ++j) { const int i = 2 * wave + j; const int tau = blk * 16 + i; const int t = tok0 + (pass ? (L - 1 - tau) : tau);
                const size_t off = (size_t)t * D + h * DH + 2 * lane;
                float o0 = 0.f, o1 = 0.f;
#pragma unroll
                for (int q = 0; q < 4; ++q) { const f32x2 x = *(const LAS f32x2*)(Lo + (i * 4 + q) * 128 + 2 * lane); o0 += x.x; o1 += x.y; }
                if (pass == 0) { *(unsigned*)(KF + off) = cvt_pk_bf16(o0, o1); }
                else { const unsigned wf = *(const unsigned*)(KF + off), wg = *(const unsigned*)(GA + off);
                    o0 += bf_lo(wf); o1 += bf_hi(wf);
                    const float ss = wave_sum(o0 * o0 + o1 * o1); const float rstd = 1.0f / sqrtf(ss * (1.f / DH) + EPS);
                    const f32x2 gh = *(const f32x2*)(ghead + h * DH + 2 * lane);
                    *(unsigned*)(GA + off) = cvt_pk_bf16(o0 * rstd * gh.x * bf_lo(wg), o1 * rstd * gh.y * bf_hi(wg)); }
            }
            __syncthreads();
        }
        VM_WAIT(); __syncthreads(); __builtin_amdgcn_fence(__ATOMIC_ACQUIRE, "agent"); VM_WAIT(); __syncthreads();
    }
}
#endif

__device__ __forceinline__ void gla_phase(LAS unsigned char* lds, unsigned char* ws, const float* ghead, int vcu, int G) {
    if (G == 256) {
        if (vcu < 64) { gla_pair_naive(lds, ws, ghead, vcu); }
        else { gla_pair_naive(lds, ws, ghead, vcu); if (vcu < 128) gla_pair_naive(lds, ws, ghead, vcu + 192); }
    } else { for (int p = vcu; p < 320; p += G) gla_pair_naive(lds, ws, ghead, p); }
}

__global__ void __launch_bounds__(NWAVES * 64, 2) fwd_kernel(Args args) {
    extern __shared__ __attribute__((aligned(16))) unsigned char lds_raw[];
    LAS unsigned char* lds = (LAS unsigned char*)lds_raw;
    volatile LAS unsigned* MISC = (volatile LAS unsigned*)(lds + MISC_OFF);
    const int tid = threadIdx.x, lane = tid & 63, wave = __builtin_amdgcn_readfirstlane(tid >> 6);
    const int G = gridDim.x; const int bx = blockIdx.x; const int vcu = (G % 8 == 0) ? (bx % 8) * (G / 8) + bx / 8 : bx;
    unsigned char* ws = args.ws;
    unsigned* ctl = (unsigned*)(ws + WS_CTL);
    for (int u = tid; u < (LDS_BYTES - LDSCTL_OFF) / 4; u += NWAVES * 64) ((LAS unsigned*)(lds + LDSCTL_OFF))[u] = 0u;
    __syncthreads();
    XcdBarrier bar; bar.bar = ctl + CW_BAR; bar.x = 0; bar.st = nullptr;
    if (MK_N_LAUNCHES == 1) bar = xcd_barrier_post(ctl + CW_BAR, MISC + 8);
    const int lo = args.ph_lo, hi = args.ph_hi;
#define IN(k) (lo <= (k) && (k) < hi)
#define BOTH(k) (IN(k) && IN((k) + 1))
#define GRID_BAR() do { if (MK_N_LAUNCHES == 1) xcd_barrier(bar); } while (0)
    Ctx cx; cx.ws = ws; cx.xp = args.in[0]; cx.xs = args.in[1]; cx.out = args.out; cx.G = G; cx.c = bx;
    const int gw = vcu * NWAVES + wave, NGW = G * NWAVES;

    if (IN(0)) {
        LAS float* scr = (LAS float*)(lds + wave * 16384);
        const float* w_in = args.in[3]; const float* w_a = args.in[7]; const float* w_b = args.in[8]; const float* w_o = args.in[9];
        constexpr int I_IN = (D / 64) * (32768 / 32), I_A = (D / 64) * (D / 32), I_B = (DB / 64) * (D / 32), I_O = I_A;
        for (int it = gw; it < I_IN + I_A + I_B + I_O; it += NGW) {
            int r = it;
            if (r < I_IN) { p0_transpose_item(w_in, D, 32768, (bf16_t*)(ws + WS_WIN), scr, r, lane); continue; } r -= I_IN;
            if (r < I_A) { p0_transpose_item(w_a, D, D, (bf16_t*)(ws + WS_WA), scr, r, lane); continue; } r -= I_A;
            if (r < I_B) { p0_transpose_item(w_b, DB, D, (bf16_t*)(ws + WS_WB), scr, r, lane); continue; } r -= I_B;
            p0_transpose_item(w_o, D, D, (bf16_t*)(ws + WS_WO), scr, r, lane);
        }
        for (int m = gw; m < TOK; m += NGW) { const float* xr = (m < NPT) ? args.in[0] + (size_t)m * D : args.in[1] + (size_t)(m - NPT) * D;
            rms_row<true>(xr, args.in[2], (bf16_t*)(ws + WS_H) + (size_t)m * D, lane); }
        for (int i = bx * 512 + tid; i < 2 * D; i += G * 512) { const float* lbp = (i < D) ? args.in[4] : args.in[5]; const int c = i & (D - 1);
            const float a0 = lbp[c], a1 = lbp[D + c]; ((float*)(ws + (i < D ? WS_LBF : WS_LBB)))[c] = 1.0f / (1.0f + expf(a1 - a0)); }
        for (int i = bx * 512 + tid; i < 1024 * 512; i += G * 512) { const int r = i >> 9, c = i & 511, j = r & 511, part = r >> 9; const float ph = (float)((j * c) & 511) * (1.f / 512.f);
            const float vv = (part ? __builtin_amdgcn_sinf(ph) : __builtin_amdgcn_cosf(ph)) * 0.04419417382415922f; ((bf16_t*)(ws + WS_DFTC))[i] = (bf16_t)f2bf(vv); }
        if (BOTH(0)) GRID_BAR();
    }
    if (IN(1)) { ProbG1a P; P.init(cx); pg8::gemm_phase(lds, P); if (BOTH(1)) GRID_BAR(); }
    if (IN(2)) { gla_phase(lds, ws, args.in[6], vcu, G); if (BOTH(2)) GRID_BAR(); }
    if (IN(3)) {
        { ProbPlain P; P.init(cx, ws + WS_GA, ws + WS_WA, ws + WS_PA, D, D); pg8::gemm_phase(lds, P); }
        { ProbG1b P; P.init(cx); pg8::gemm_phase(lds, P); }
        for (size_t i = ((size_t)bx * 512 + tid) * 2; i < (size_t)LP * 2 * LP; i += (size_t)G * 1024) { const int lp = (int)(i >> 14), kk = (int)(i & 16383), part = kk >> 13, l = kk & 8191;
            const float p0 = (float)((lp * l) & 8191) * (1.f / 8192.f), p1 = (float)((lp * (l + 1)) & 8191) * (1.f / 8192.f); const float sc = 0.011048543456039806f;
            const float v0 = part ? -__builtin_amdgcn_sinf(p0) : __builtin_amdgcn_cosf(p0), v1 = part ? -__builtin_amdgcn_sinf(p1) : __builtin_amdgcn_cosf(p1);
            *(unsigned*)((bf16_t*)(ws + WS_DFTS8) + i) = cvt_pk_bf16(v0 * sc, v1 * sc); }
        for (size_t i = ((size_t)bx * 512 + tid) * 2; i < (size_t)LSQ * 2 * LSQ; i += (size_t)G * 1024) { const int lp = (int)(i >> 12), kk = (int)(i & 4095), part = kk >> 11, l = kk & 2047;
            const float p0 = (float)((lp * l) & 2047) * (1.f / 2048.f), p1 = (float)((lp * (l + 1)) & 2047) * (1.f / 2048.f); const float sc = 0.022097086912079608f;
            const float v0 = part ? -__builtin_amdgcn_sinf(p0) : __builtin_amdgcn_cosf(p0), v1 = part ? -__builtin_amdgcn_sinf(p1) : __builtin_amdgcn_cosf(p1);
            *(unsigned*)((bf16_t*)(ws + WS_DFTS2) + i) = cvt_pk_bf16(v0 * sc, v1 * sc); }
        if (BOTH(3)) GRID_BAR();
    }
    if (IN(4)) { ProbDft1 P; P.init(cx); pg8::gemm_phase(lds, P); if (BOTH(4)) GRID_BAR(); }
    if (IN(5)) { { ProbDft2 P; P.init(cx, 0); pg8::gemm_phase(lds, P); } { ProbDft2 P; P.init(cx, 1); pg8::gemm_phase(lds, P); } if (BOTH(5)) GRID_BAR(); }
    if (IN(6)) { ProbPlain P; P.init(cx, ws + WS_BOUT, ws + WS_WB, ws + WS_PB, D, DB); pg8::gemm_phase(lds, P); if (BOTH(6)) GRID_BAR(); }
    if (IN(7)) { ProbMerge P; P.init(cx); pg8::gemm_phase(lds, P); if (BOTH(7)) GRID_BAR(); }
    if (IN(8)) { ProbOut P; P.init(cx); pg8::gemm_phase(lds, P); if (BOTH(8)) GRID_BAR(); }
    if (IN(9)) { for (int m = gw; m < TOK; m += NGW) rms_row<false>(args.out + (size_t)m * D, args.in[10], args.out + (size_t)m * D, lane); }
#undef IN
#undef BOTH
#undef GRID_BAR
}

extern "C" void kernel_launch(void* const* d_in, const int* in_sizes, int n_in, void* d_out, int out_size, void* d_ws, size_t ws_size, hipStream_t stream) {
    static int grid = 0;
    if (grid == 0) {
        if (n_in != 11 || ws_size < WS_END) { fprintf(stderr, "kernel_launch: need 11 inputs and >= %zu bytes of workspace (got %d, %zu)\n", (size_t)WS_END, n_in, ws_size); grid = -1; return; }
        int dev = 0, cus = 0;
        if (hipGetDevice(&dev) != hipSuccess || hipDeviceGetAttribute(&cus, hipDeviceAttributeMultiprocessorCount, dev) != hipSuccess) { grid = -1; return; }
        if (hipFuncSetAttribute((const void*)fwd_kernel, hipFuncAttributeMaxDynamicSharedMemorySize, LDS_BYTES) != hipSuccess) { fprintf(stderr, "kernel_launch: hipFuncSetAttribute failed\n"); grid = -1; return; }
        int per_cu = 0;
        if (hipOccupancyMaxActiveBlocksPerMultiprocessor(&per_cu, (const void*)fwd_kernel, NWAVES * 64, LDS_BYTES) != hipSuccess || per_cu < 1) fprintf(stderr, "kernel_launch: occupancy query reports %d\n", per_cu);
        (void)hipGetLastError();
        grid = cus;
    }
    if (grid < 0) return;
    (void)hipMemsetAsync((char*)d_ws + WS_CTL, 0, CTL_ZERO_BYTES, stream);
    Args a{};
    for (int i = 0; i < 11; ++i) a.in[i] = (const float*)d_in[i];
    a.out = (float*)d_out; a.ws = (unsigned char*)d_ws;
    if (MK_N_LAUNCHES == 1) { a.ph_lo = 0; a.ph_hi = N_PHASES; hipLaunchKernelGGL(fwd_kernel, dim3(grid), dim3(NWAVES * 64), LDS_BYTES, stream, a); }
    else for (int li = 0; li < N_PHASES; ++li) { a.ph_lo = li; a.ph_hi = li + 1; hipLaunchKernelGGL(fwd_kernel, dim3(grid), dim3(NWAVES * 64), LDS_BYTES, stream, a); }
}
```

```cpp
#include <hip/hip_runtime.h>
#include <cstdio>
#include <cstdint>

#define LAS __attribute__((address_space(3)))
#define GAS __attribute__((address_space(1)))
typedef unsigned short bf16_t;
typedef short bf16x8 __attribute__((ext_vector_type(8)));
typedef short bf16x4 __attribute__((ext_vector_type(4)));
typedef float f32x2 __attribute__((ext_vector_type(2)));
typedef float f32x4 __attribute__((ext_vector_type(4)));
typedef float f32x16 __attribute__((ext_vector_type(16)));
typedef unsigned u32x2 __attribute__((ext_vector_type(2)));
typedef unsigned u32x4 __attribute__((ext_vector_type(4)));

#ifndef MK_N_LAUNCHES
#define MK_N_LAUNCHES 1
#endif
#ifndef GLA_NAIVE
#define GLA_NAIVE 1
#endif

constexpr int D = 4096, TOK = 32768, NPT = 16384, LP = 8192, LSQ = 2048, NH = 32, DH = 128, DB = 2048, CG = 512;
constexpr int C_U = 20480, C_MA = 24576, C_MB = 28672;
constexpr float EPS = 1e-6f;
constexpr int N_PHASES = 10;

constexpr size_t MiB = 1u << 20;
constexpr size_t WS_CTL = 0, CTL_ZERO_BYTES = 1 * MiB;
constexpr size_t WS_LBF = 1 * MiB, WS_LBB = 1 * MiB + 16384;
constexpr size_t WS_WIN = 2 * MiB, WS_WA = 258 * MiB, WS_WB = 290 * MiB, WS_WO = 306 * MiB, WS_H = 338 * MiB;
constexpr size_t WS_Q = 594 * MiB, WS_KF = 850 * MiB, WS_KB = 1106 * MiB, WS_V = 1362 * MiB, WS_GA = 1618 * MiB;
constexpr size_t WS_DFTC = 1874 * MiB, WS_DFTS2 = 1876 * MiB, WS_BOUT = 1892 * MiB, WS_END = 2020 * MiB;
constexpr size_t WS_PA = WS_Q, WS_U = WS_KF, WS_SGB = WS_KF + 128 * MiB, WS_M = WS_KF, WS_ABT = WS_KB, WS_DFTS8 = WS_V, WS_PB = WS_GA;
constexpr size_t ABT_SAMPLE_OFF = (size_t)2 * 2048 * 16384;
constexpr int CW_TMO = 0, CW_BAR = 4096;

constexpr int RING_BYTES = 131072;
constexpr int LDSCTL_OFF = RING_BYTES, MISC_OFF = LDSCTL_OFF + 320;
constexpr int LDS_BYTES = 147456;
constexpr int NWAVES = 8;

__device__ __forceinline__ unsigned cvt_pk_bf16(float lo, float hi) { unsigned r; asm("v_cvt_pk_bf16_f32 %0, %1, %2" : "=v"(r) : "v"(lo), "v"(hi)); return r; }
__device__ __forceinline__ float bf_lo(unsigned w) { return __uint_as_float(w << 16); }
__device__ __forceinline__ float bf_hi(unsigned w) { return __uint_as_float(w & 0xffff0000u); }
__device__ __forceinline__ float fexp(float x) { return __builtin_amdgcn_exp2f(x * 1.44269504089f); }
__device__ __forceinline__ float frcp(float x) { return __builtin_amdgcn_rcpf(x); }
__device__ __forceinline__ float fsig(float x) { return frcp(1.f + fexp(-x)); }
__device__ __forceinline__ float fsilu(float x) { return x * fsig(x); }
__device__ __forceinline__ float flog(float x) { return __builtin_amdgcn_logf(x) * 0.69314718056f; }
__device__ __forceinline__ float wave_sum(float v) {
#pragma unroll
    for (int o = 1; o < 64; o <<= 1) v += __shfl_xor(v, o);
    return v;
}
#define LDS_WAIT() asm volatile("s_waitcnt lgkmcnt(0)" ::: "memory")
#define VM_WAIT() asm volatile("s_waitcnt vmcnt(0)" ::: "memory")

namespace pg8 {
constexpr int BM = 256, BK = 64, HALF = 128, HTB = HALF * BK * 2, STAGE_BYTES = 8 * HTB, NXCD = 8, WGM = 8;
__host__ __device__ __forceinline__ int lds_byte(int r, int c) { const int st = (r >> 4) * 2 + (c >> 5), rr = r & 15, cc = c & 31, ob = rr * 64 + cc * 2; return st * 1024 + (ob ^ (((ob >> 9) & 1) << 5)); }
__host__ __device__ __forceinline__ void stage_rc(int b, int& R, int& C) { const int st = b / 1024, sb = b % 1024, swz = sb ^ (((sb >> 9) & 1) << 5); R = (st >> 1) * 16 + swz / 64; C = (st & 1) * 32 + (swz % 64) / 2; }
__host__ __device__ __forceinline__ int perm32(int rho) { const int n = rho >> 4, i = rho & 15; return 8 * (i >> 2) + 4 * n + (i & 3); }

struct Unit { int pm, pn; };
struct Ptrs { const char* a0; const char* a1; const char* b0; const char* b1; };

struct StaticOrder {
    int nM, nN, nwg, G, c;
    __host__ __device__ void init(int M, int N, int G_, int c_) { nM = M / BM; nN = N / BM; nwg = nM * nN; G = G_; c = c_; }
    __host__ __device__ bool next(int i, Unit& u) const {
        const long L = (long)i * G + c; if (L >= nwg) return false;
        int wgid = (int)L; { const int q = nwg / NXCD, r = nwg % NXCD, xcd = wgid % NXCD, off = wgid / NXCD; wgid = (xcd < r ? xcd * (q + 1) : r * (q + 1) + (xcd - r) * q) + off; }
        const int nig = WGM * nN, gid = wgid / nig, fm = gid * WGM, gsz = (nM - fm) < WGM ? (nM - fm) : WGM;
        u.pm = fm + ((wgid % nig) % gsz); u.pn = (wgid % nig) / gsz; return true;
    }
};

template <class P>
__device__ __forceinline__ void gemm_phase(LAS unsigned char* lds, const P& p) {
    const int tid = threadIdx.x, wid = __builtin_amdgcn_readfirstlane(tid >> 6), lane = tid & 63, wr = wid >> 2, wc = wid & 3, fr = lane & 15, fq = lane >> 4;
    const int nt = p.nt;
    unsigned voffA[2], voffB[2];
#pragma unroll
    for (int i = 0; i < 2; ++i) { int R, C; stage_rc(tid * 16 + i * 8192, R, C); const int Rb = P::PERM ? ((R & ~31) + perm32(R & 31)) : R;
        voffA[i] = (unsigned)(R * p.lda + C) * 2u; voffB[i] = (unsigned)(Rb * p.ldb + C) * 2u; }
    const size_t kstep = (size_t)(BK * 2);
    const unsigned ldsw = (unsigned)wid * 1024u;
    const int aoff = lds_byte(wr * 64 + fr, fq * 8), boff = lds_byte(wc * 32 + fr, fq * 8);
#define PG8_SA(b, h) (((b) * 2 + (h)) * HTB)
#define PG8_SB(b, h) ((4 + (b) * 2 + (h)) * HTB)
#define PG8_STAGE(bufoff, gbase, voff) do { _Pragma("unroll") for (int _i = 0; _i < 2; ++_i) \
        __builtin_amdgcn_global_load_lds((const unsigned*)((const char*)(gbase) + (voff)[_i]), (LAS unsigned*)(lds + (bufoff) + ldsw + _i * 8192), 16, 0, 0); } while (0)
#define PG8_LDA(dst, b, h) do { _Pragma("unroll") for (int m = 0; m < 4; ++m) _Pragma("unroll") for (int k = 0; k < 2; ++k) dst[m][k] = *(const LAS bf16x8*)(lds + PG8_SA(b, h) + aoff + m * 2048 + k * 1024); } while (0)
#define PG8_LDB(dst, b, h) do { _Pragma("unroll") for (int n = 0; n < 2; ++n) _Pragma("unroll") for (int k = 0; k < 2; ++k) dst[n][k] = *(const LAS bf16x8*)(lds + PG8_SB(b, h) + boff + n * 2048 + k * 1024); } while (0)
#define PG8_MMA(ai, bj, At, Bt) do { __builtin_amdgcn_s_setprio(1); _Pragma("unroll") for (int m = 0; m < 4; ++m) _Pragma("unroll") for (int n = 0; n < 2; ++n) _Pragma("unroll") for (int k = 0; k < 2; ++k) \
        acc[ai][bj][m][n] = __builtin_amdgcn_mfma_f32_16x16x32_bf16(Bt[n][k], At[m][k], acc[ai][bj][m][n], 0, 0, 0); __builtin_amdgcn_s_setprio(0); } while (0)
#define PG8_WAIT_V(n) asm volatile("s_waitcnt vmcnt(" #n ")" ::: "memory")
#define PG8_WAIT_L(n) asm volatile("s_waitcnt lgkmcnt(" #n ")" ::: "memory")
#define PG8_BAR __builtin_amdgcn_s_barrier()
#define PG8_SCHED __builtin_amdgcn_sched_barrier(0)
    Unit cur, nxt; int ui = 0;
    if (!p.next(0, cur)) return;
    f32x4 acc[2][2][4][2];
#pragma unroll
    for (int a = 0; a < 2; ++a)
#pragma unroll
        for (int b = 0; b < 2; ++b)
#pragma unroll
            for (int m = 0; m < 4; ++m)
#pragma unroll
                for (int n = 0; n < 2; ++n) acc[a][b][m][n] = (f32x4){0.f, 0.f, 0.f, 0.f};
    bf16x8 At[4][2], B0[2][2], B1[2][2];
    Ptrs cq; p.ptrs(cur, cq);
    PG8_STAGE(PG8_SB(0, 0), cq.b0, voffB); PG8_STAGE(PG8_SB(0, 1), cq.b1, voffB); PG8_STAGE(PG8_SA(0, 0), cq.a0, voffA); PG8_STAGE(PG8_SA(0, 1), cq.a1, voffA);
    if (wr == 1) PG8_BAR;
    PG8_WAIT_V(2); PG8_BAR;
    PG8_STAGE(PG8_SB(1, 0), cq.b0 + kstep, voffB); PG8_STAGE(PG8_SA(1, 0), cq.a0 + kstep, voffA); PG8_STAGE(PG8_SB(1, 1), cq.b1 + kstep, voffB);
    PG8_WAIT_V(6); PG8_BAR;
    for (;;) {
        const bool has_next = p.next(ui + 1, nxt);
        Ptrs nq = cq; if (has_next) p.ptrs(nxt, nq);
        for (int t = 0; t < nt; t += 2) {
            const bool last = (t == nt - 2);
            const size_t o1 = (size_t)(t + 1) * kstep, o2 = (size_t)(t + 2) * kstep;
            const char* a1_1 = cq.a1 + o1;
            const char* a2_0 = last ? nq.a0 : cq.a0 + o2; const char* a2_1 = last ? nq.a1 : cq.a1 + o2;
            const char* b2_0 = last ? nq.b0 : cq.b0 + o2; const char* b2_1 = last ? nq.b1 : cq.b1 + o2;
            PG8_LDB(B0, 0, 0); PG8_LDB(B1, 0, 1); PG8_SCHED; PG8_LDA(At, 0, 0); PG8_STAGE(PG8_SA(1, 1), a1_1, voffA);
            PG8_WAIT_V(8); PG8_WAIT_L(0); PG8_BAR; PG8_MMA(0, 0, At, B0); PG8_MMA(0, 1, At, B1); PG8_BAR; PG8_SCHED;
            PG8_LDA(At, 0, 1); PG8_STAGE(PG8_SB(0, 0), b2_0, voffB); PG8_STAGE(PG8_SB(0, 1), b2_1, voffB); PG8_STAGE(PG8_SA(0, 0), a2_0, voffA);
            PG8_WAIT_V(8); PG8_WAIT_L(0); PG8_BAR; PG8_MMA(1, 0, At, B0); PG8_MMA(1, 1, At, B1); PG8_BAR; PG8_SCHED;
            PG8_LDB(B0, 1, 0); PG8_LDB(B1, 1, 1); PG8_SCHED; PG8_LDA(At, 1, 0); PG8_STAGE(PG8_SA(0, 1), a2_1, voffA);
            PG8_WAIT_V(8); PG8_WAIT_L(0); PG8_BAR; PG8_MMA(0, 0, At, B0); PG8_MMA(0, 1, At, B1); PG8_BAR; PG8_SCHED;
            PG8_LDA(At, 1, 1); PG8_STAGE(PG8_SB(1, 0), b2_0 + kstep, voffB); PG8_STAGE(PG8_SB(1, 1), b2_1 + kstep, voffB); PG8_STAGE(PG8_SA(1, 0), a2_0 + kstep, voffA);
            PG8_WAIT_V(8); PG8_WAIT_L(0); PG8_BAR; PG8_MMA(1, 0, At, B0); PG8_MMA(1, 1, At, B1); PG8_BAR; PG8_SCHED;
        }
        if (wr == 0) PG8_BAR;
        p.epi(acc, cur, wr, wc, fr, fq);
        if (!has_next) break;
#pragma unroll
        for (int a = 0; a < 2; ++a)
#pragma unroll
            for (int b = 0; b < 2; ++b)
#pragma unroll
                for (int m = 0; m < 4; ++m)
#pragma unroll
                    for (int n = 0; n < 2; ++n) acc[a][b][m][n] = (f32x4){0.f, 0.f, 0.f, 0.f};
        cur = nxt; cq = nq; ++ui;
        if (wr == 1) PG8_BAR;
    }
    PG8_WAIT_V(0);
    PG8_BAR;
#undef PG8_SA
#undef PG8_SB
#undef PG8_STAGE
#undef PG8_LDA
#undef PG8_LDB
#undef PG8_MMA
#undef PG8_WAIT_V
#undef PG8_WAIT_L
#undef PG8_BAR
#undef PG8_SCHED
}
}

#define XB_TMO      128
#define XB_XCNT(j)  (256  + 64 * (j))
#define XB_XSUB(j)  (1280 + 64 * (j))
#define XB_XGEN(j)  (2304 + 64 * (j))
#define XB_TOP      3328
#define XB_TOPGEN   3392
#define XCD_BAR_WORDS 3456
#define XB_SPIN_CAP (1u << 18)
__device__ __forceinline__ unsigned xb_ld(unsigned* p)              { return __hip_atomic_load(p, __ATOMIC_RELAXED, __HIP_MEMORY_SCOPE_AGENT); }
__device__ __forceinline__ unsigned xb_add(unsigned* p, unsigned v) { return __hip_atomic_fetch_add(p, v, __ATOMIC_RELAXED, __HIP_MEMORY_SCOPE_AGENT); }
__device__ __forceinline__ unsigned xb_xcc_id() { return (unsigned)__builtin_amdgcn_s_getreg((3 << 11) | 20) & 0xFu; }
#define XB_SPIN(cond, bar) do { unsigned _sp = 0; while (cond) { __builtin_amdgcn_s_sleep(1); \
    if ((++_sp & 255u) == 0u) { if (xb_ld(&(bar)[XB_TMO])) break; if (_sp > XB_SPIN_CAP) { atomicAdd(&(bar)[XB_TMO], 1u); break; } } } } while (0)
struct XcdBarrier { unsigned* bar; unsigned x; volatile LAS unsigned* st; };
__device__ __forceinline__ XcdBarrier xcd_barrier_post(unsigned* bar, volatile LAS unsigned* st) {
    XcdBarrier b; b.bar = bar; b.x = xb_xcc_id(); b.st = st;
    if (threadIdx.x == 0) (void)xb_add(&bar[XB_XCNT(b.x)], 1u);
    return b;
}
__device__ __forceinline__ void xcd_barrier_complete(unsigned* bar, unsigned x, unsigned& nloc, unsigned& nx) {
    const unsigned G = gridDim.x * gridDim.y * gridDim.z;
    unsigned sum, cnt, mine, sp = 0u;
    for (;;) {
        sum = 0u; cnt = 0u; mine = 0u;
#pragma unroll
        for (unsigned j = 0; j < 16; ++j) { const unsigned c = xb_ld(&bar[XB_XCNT(j)]); sum += c; cnt += (c > 0u) ? 1u : 0u; mine = (j == x) ? c : mine; }
        if (sum == G) break;
        __builtin_amdgcn_s_sleep(1);
        if ((++sp & 255u) == 0u) { if (xb_ld(&bar[XB_TMO])) break; if (sp > XB_SPIN_CAP) { atomicAdd(&bar[XB_TMO], 1u); break; } }
    }
    nloc = mine > 0u ? mine : 1u; nx = cnt > 0u ? cnt : 1u;
}
__device__ __forceinline__ void xcd_barrier(const XcdBarrier& b) {
    asm volatile("s_waitcnt vmcnt(0)" ::: "memory");
    __syncthreads();
    if (threadIdx.x == 0) {
        unsigned* bar = b.bar;
        __builtin_amdgcn_s_waitcnt(0);
        unsigned nloc = b.st[0], nx = b.st[1];
        if (nloc == 0u) { xcd_barrier_complete(bar, b.x, nloc, nx); b.st[0] = nloc; b.st[1] = nx; }
        const unsigned old = xb_add(&bar[XB_XSUB(b.x)], 1u);
        const unsigned gen = old / nloc;
        if (old + 1u == (gen + 1u) * nloc) {
            __builtin_amdgcn_fence(__ATOMIC_RELEASE, "agent");
            asm volatile("s_waitcnt vmcnt(0)" ::: "memory");
            const unsigned og = xb_add(&bar[XB_TOP], 1u);
            const unsigned tg = og / nx;
            if (og + 1u == (tg + 1u) * nx) xb_add(&bar[XB_TOPGEN], 1u);
            else XB_SPIN(xb_ld(&bar[XB_TOPGEN]) == tg, bar);
            __builtin_amdgcn_fence(__ATOMIC_ACQUIRE, "agent");
            xb_add(&bar[XB_XGEN(b.x)], 1u);
            asm volatile("s_waitcnt vmcnt(0)" ::: "memory");
        } else {
            XB_SPIN(xb_ld(&bar[XB_XGEN(b.x)]) == gen, bar);
            __builtin_amdgcn_fence(__ATOMIC_ACQUIRE, "agent");
            asm volatile("s_waitcnt vmcnt(0)" ::: "memory");
        }
    }
    __syncthreads();
}

struct Ctx { unsigned char* ws; const float* xp; const float* xs; float* out; int G, c; };

template <class F> __device__ __forceinline__ void epi_store_bf16(const f32x4 (&acc)[2][2][4][2], bf16_t* tile  , size_t ldc, const F& f) {
#pragma unroll
    for (int ai = 0; ai < 2; ++ai)
#pragma unroll
        for (int m = 0; m < 4; ++m) { bf16_t* rowp = tile + (size_t)(ai * 128 + m * 16) * ldc;
#pragma unroll
            for (int bj = 0; bj < 2; ++bj) { f32x4 v0 = acc[ai][bj][m][0], v1 = acc[ai][bj][m][1];
                f(v0, v1, bj, ai * 128 + m * 16);
                u32x4 w; w.x = cvt_pk_bf16(v0[0], v0[1]); w.y = cvt_pk_bf16(v0[2], v0[3]); w.z = cvt_pk_bf16(v1[0], v1[1]); w.w = cvt_pk_bf16(v1[2], v1[3]);
                *(u32x4*)(rowp + bj * 128) = w; } }
}
struct FIdent { __device__ __forceinline__ void operator()(f32x4&, f32x4&, int, int) const {} };
struct FSilu { float s; __device__ __forceinline__ void operator()(f32x4& a, f32x4& b, int, int) const {
#pragma unroll
    for (int e = 0; e < 4; ++e) { a[e] = fsilu(a[e]) * s; b[e] = fsilu(b[e]) * s; } } };
struct FLogF { f32x4 lb[2][2]; __device__ __forceinline__ void operator()(f32x4& a, f32x4& b, int bj, int) const {
#pragma unroll
    for (int e = 0; e < 4; ++e) { const float l0 = lb[bj][0][e], l1 = lb[bj][1][e];
        a[e] = flog(l0 + (1.f - l0) * fsig(a[e])); b[e] = flog(l1 + (1.f - l1) * fsig(b[e])); } } };

struct ProbG1a {
    static constexpr bool PERM = true;
    pg8::StaticOrder S; int lda, ldb, nt; unsigned char* ws;
    __device__ __forceinline__ void init(const Ctx& c) { S.init(TOK, 20480, c.G, c.c); lda = D; ldb = D; nt = D / 64; ws = c.ws; }
    __device__ __forceinline__ bool next(int i, pg8::Unit& u) const { return S.next(i, u); }
    __device__ __forceinline__ void ptrs(const pg8::Unit& u, pg8::Ptrs& q) const {
        q.a0 = (const char*)(ws + WS_H) + (size_t)u.pm * 256 * D * 2; q.a1 = q.a0 + (size_t)128 * D * 2;
        q.b0 = (const char*)(ws + WS_WIN) + (size_t)u.pn * 256 * D * 2; q.b1 = q.b0 + (size_t)128 * D * 2; }
    __device__ __forceinline__ void epi(const f32x4 (&acc)[2][2][4][2], const pg8::Unit& u, int wr, int wc, int fr, int fq) const {
        const int seg = u.pn >> 4, colt = (u.pn & 15) * 256 + wc * 32 + 8 * fq, row0 = u.pm * 256 + wr * 64 + fr;
        bf16_t* tile = (bf16_t*)(ws + WS_Q + (size_t)seg * 256 * MiB) + (size_t)row0 * D + colt;
        if (seg == 0) { FSilu f{0.08838834764831845f}; epi_store_bf16(acc, tile, D, f); }
        else if (seg == 1 || seg == 2) { const float* lb = (const float*)(ws + (seg == 1 ? WS_LBF : WS_LBB)) + colt; FLogF f;
#pragma unroll
            for (int bj = 0; bj < 2; ++bj)
#pragma unroll
                for (int n = 0; n < 2; ++n) f.lb[bj][n] = *(const f32x4*)(lb + bj * 128 + 4 * n);
            epi_store_bf16(acc, tile, D, f); }
        else if (seg == 3) { FIdent f; epi_store_bf16(acc, tile, D, f); }
        else { FSilu f{1.f}; epi_store_bf16(acc, tile, D, f); }
    }
};
struct ProbPlain {
    static constexpr bool PERM = true;
    pg8::StaticOrder S; int lda, ldb, nt; const char* A; const char* B; bf16_t* C; int ldc;
    __device__ __forceinline__ void init(const Ctx& c, const void* A_, const void* B_, void* C_, int N, int K) { S.init(TOK, N, c.G, c.c); lda = K; ldb = K; nt = K / 64; A = (const char*)A_; B = (const char*)B_; C = (bf16_t*)C_; ldc = N; }
    __device__ __forceinline__ bool next(int i, pg8::Unit& u) const { return S.next(i, u); }
    __device__ __forceinline__ void ptrs(const pg8::Unit& u, pg8::Ptrs& q) const {
        q.a0 = A + (size_t)u.pm * 256 * lda * 2; q.a1 = q.a0 + (size_t)128 * lda * 2; q.b0 = B + (size_t)u.pn * 256 * ldb * 2; q.b1 = q.b0 + (size_t)128 * ldb * 2; }
    __device__ __forceinline__ void epi(const f32x4 (&acc)[2][2][4][2], const pg8::Unit& u, int wr, int wc, int fr, int fq) const {
        bf16_t* tile = C + (size_t)(u.pm * 256 + wr * 64 + fr) * ldc + u.pn * 256 + wc * 32 + 8 * fq; FIdent f; epi_store_bf16(acc, tile, ldc, f); }
};
struct ProbG1b {
    static constexpr bool PERM = true;
    pg8::StaticOrder S; int lda, ldb, nt; unsigned char* ws;
    __device__ __forceinline__ void init(const Ctx& c) { S.init(TOK, 4096, c.G, c.c); lda = D; ldb = D; nt = D / 64; ws = c.ws; }
    __device__ __forceinline__ bool next(int i, pg8::Unit& u) const { return S.next(i, u); }
    __device__ __forceinline__ void ptrs(const pg8::Unit& u, pg8::Ptrs& q) const {
        q.a0 = (const char*)(ws + WS_H) + (size_t)u.pm * 256 * D * 2; q.a1 = q.a0 + (size_t)128 * D * 2;
        q.b0 = (const char*)(ws + WS_WIN) + (size_t)(C_U + u.pn * 256) * D * 2; q.b1 = q.b0 + (size_t)128 * D * 2; }
    __device__ __forceinline__ void epi(const f32x4 (&acc)[2][2][4][2], const pg8::Unit& u, int wr, int wc, int fr, int fq) const {
        const int seg = u.pn >> 3, colt = (u.pn & 7) * 256 + wc * 32 + 8 * fq, row0 = u.pm * 256 + wr * 64 + fr;
        bf16_t* tile = (bf16_t*)(ws + (seg ? WS_SGB : WS_U)) + (size_t)row0 * DB + colt;
        if (seg == 0) { FIdent f; epi_store_bf16(acc, tile, DB, f); } else { FSilu f{1.f}; epi_store_bf16(acc, tile, DB, f); }
    }
};
struct ProbDft1 {
    static constexpr bool PERM = true;
    pg8::StaticOrder S; int lda, ldb, nt; unsigned char* ws;
    __device__ __forceinline__ void init(const Ctx& c) { S.init(4096, TOK, c.G, c.c); lda = CG; ldb = DB; nt = CG / 64; ws = c.ws; }
    __device__ __forceinline__ bool next(int i, pg8::Unit& u) const { return S.next(i, u); }
    __device__ __forceinline__ void ptrs(const pg8::Unit& u, pg8::Ptrs& q) const {
        const int g = u.pm >> 2, pmr = u.pm & 3;
        q.a0 = (const char*)(ws + WS_DFTC) + (size_t)pmr * 256 * CG * 2; q.a1 = q.a0 + (size_t)128 * CG * 2;
        q.b0 = (const char*)(ws + WS_U) + ((size_t)u.pn * 256 * DB + (size_t)g * CG) * 2; q.b1 = q.b0 + (size_t)128 * DB * 2; }
    __device__ __forceinline__ void epi(const f32x4 (&acc)[2][2][4][2], const pg8::Unit& u, int wr, int wc, int fr, int fq) const {
        const int g = u.pm >> 2, pmr = u.pm & 3, part = pmr >> 1, j0 = (pmr & 1) * 256 + wr * 64 + fr;
        const int tt = u.pn; size_t base; int L, l0;
        if (tt < 64) { L = LP; base = (size_t)(tt >> 5) * 2048 * (2 * LP); l0 = (tt & 31) * 256; }
        else { const int ts = tt - 64; L = LSQ; base = ABT_SAMPLE_OFF + (size_t)(ts >> 3) * 2048 * (2 * LSQ); l0 = (ts & 7) * 256; }
        bf16_t* tile = (bf16_t*)(ws + WS_ABT) + base + (size_t)(g * CG + j0) * (2 * L) + (size_t)part * L + l0 + wc * 32 + 8 * fq;
        FIdent f; epi_store_bf16(acc, tile, (size_t)2 * L, f);
    }
};
struct FMulG { const bf16_t* g; __device__ __forceinline__ void operator()(f32x4& a, f32x4& b, int bj, int roff) const {
    const u32x4 w = *(const u32x4*)(g + (size_t)roff * DB + bj * 128);
    a[0] *= bf_lo(w.x); a[1] *= bf_hi(w.x); a[2] *= bf_lo(w.y); a[3] *= bf_hi(w.y); b[0] *= bf_lo(w.z); b[1] *= bf_hi(w.z); b[2] *= bf_lo(w.w); b[3] *= bf_hi(w.w); } };
struct ProbDft2 {
    static constexpr bool PERM = true;
    pg8::StaticOrder S; int lda, ldb, nt; unsigned char* ws; int L, lshift; size_t abt_off, dfts_off; int tok0;
    __device__ __forceinline__ void init(const Ctx& c, int sample) { S.init(16384, DB, c.G, c.c); ws = c.ws;
        if (!sample) { L = LP; lshift = 5; abt_off = 0; dfts_off = WS_DFTS8; tok0 = 0; } else { L = LSQ; lshift = 3; abt_off = ABT_SAMPLE_OFF; dfts_off = WS_DFTS2; tok0 = NPT; }
        lda = 2 * L; ldb = 2 * L; nt = 2 * L / 64; }
    __device__ __forceinline__ bool next(int i, pg8::Unit& u) const { return S.next(i, u); }
    __device__ __forceinline__ void ptrs(const pg8::Unit& u, pg8::Ptrs& q) const {
        const int b = u.pm >> lshift, pml = u.pm & ((1 << lshift) - 1);
        q.a0 = (const char*)(ws + dfts_off) + (size_t)pml * 256 * (2 * L) * 2; q.a1 = q.a0 + (size_t)128 * (2 * L) * 2;
        q.b0 = (const char*)(ws + WS_ABT) + (abt_off + (size_t)b * 2048 * (2 * L) + (size_t)u.pn * 256 * (2 * L)) * 2; q.b1 = q.b0 + (size_t)128 * (2 * L) * 2; }
    __device__ __forceinline__ void epi(const f32x4 (&acc)[2][2][4][2], const pg8::Unit& u, int wr, int wc, int fr, int fq) const {
        const size_t off = (size_t)(tok0 + u.pm * 256 + wr * 64 + fr) * DB + u.pn * 256 + wc * 32 + 8 * fq;
        FMulG f{(const bf16_t*)(ws + WS_SGB) + off}; epi_store_bf16(acc, (bf16_t*)(ws + WS_BOUT) + off, DB, f);
    }
};
struct ProbMerge {
    static constexpr bool PERM = true;
    pg8::StaticOrder S; int lda, ldb, nt; unsigned char* ws;
    __device__ __forceinline__ void init(const Ctx& c) { S.init(TOK, 8192, c.G, c.c); lda = D; ldb = D; nt = D / 64; ws = c.ws; }
    __device__ __forceinline__ bool next(int i, pg8::Unit& u) const { return S.next(i, u); }
    __device__ __forceinline__ void ptrs(const pg8::Unit& u, pg8::Ptrs& q) const {
        q.a0 = (const char*)(ws + WS_H) + (size_t)u.pm * 256 * D * 2; q.a1 = q.a0 + (size_t)128 * D * 2;
        q.b0 = (const char*)(ws + WS_WIN) + (size_t)(C_MA + u.pn * 128) * D * 2; q.b1 = (const char*)(ws + WS_WIN) + (size_t)(C_MB + u.pn * 128) * D * 2; }
    __device__ __forceinline__ void epi(const f32x4 (&acc)[2][2][4][2], const pg8::Unit& u, int wr, int wc, int fr, int fq) const {
        const size_t off0 = (size_t)(u.pm * 256 + wr * 64 + fr) * D + u.pn * 128 + wc * 32 + 8 * fq;
        const bf16_t* pa = (const bf16_t*)(ws + WS_PA) + off0; const bf16_t* pb = (const bf16_t*)(ws + WS_PB) + off0; bf16_t* mo = (bf16_t*)(ws + WS_M) + off0;
#pragma unroll
        for (int ai = 0; ai < 2; ++ai)
#pragma unroll
            for (int m = 0; m < 4; ++m) { const size_t ro = (size_t)(ai * 128 + m * 16) * D;
                const u32x4 wa = *(const u32x4*)(pa + ro), wb = *(const u32x4*)(pb + ro);
                const f32x4 a0 = acc[ai][0][m][0], a1 = acc[ai][0][m][1], b0 = acc[ai][1][m][0], b1 = acc[ai][1][m][1];
                float r[8];
                r[0] = fsig(a0[0]) * bf_lo(wa.x) + fsig(b0[0]) * bf_lo(wb.x); r[1] = fsig(a0[1]) * bf_hi(wa.x) + fsig(b0[1]) * bf_hi(wb.x);
                r[2] = fsig(a0[2]) * bf_lo(wa.y) + fsig(b0[2]) * bf_lo(wb.y); r[3] = fsig(a0[3]) * bf_hi(wa.y) + fsig(b0[3]) * bf_hi(wb.y);
                r[4] = fsig(a1[0]) * bf_lo(wa.z) + fsig(b1[0]) * bf_lo(wb.z); r[5] = fsig(a1[1]) * bf_hi(wa.z) + fsig(b1[1]) * bf_hi(wb.z);
                r[6] = fsig(a1[2]) * bf_lo(wa.w) + fsig(b1[2]) * bf_lo(wb.w); r[7] = fsig(a1[3]) * bf_hi(wa.w) + fsig(b1[3]) * bf_hi(wb.w);
                u32x4 w; w.x = cvt_pk_bf16(r[0], r[1]); w.y = cvt_pk_bf16(r[2], r[3]); w.z = cvt_pk_bf16(r[4], r[5]); w.w = cvt_pk_bf16(r[6], r[7]);
                *(u32x4*)(mo + ro) = w; }
    }
};
struct ProbOut {
    static constexpr bool PERM = false;
    pg8::StaticOrder S; int lda, ldb, nt; unsigned char* ws; const float* xp; const float* xs; float* out;
    __device__ __forceinline__ void init(const Ctx& c) { S.init(TOK, D, c.G, c.c); lda = D; ldb = D; nt = D / 64; ws = c.ws; xp = c.xp; xs = c.xs; out = c.out; }
    __device__ __forceinline__ bool next(int i, pg8::Unit& u) const { return S.next(i, u); }
    __device__ __forceinline__ void ptrs(const pg8::Unit& u, pg8::Ptrs& q) const {
        q.a0 = (const char*)(ws + WS_M) + (size_t)u.pm * 256 * D * 2; q.a1 = q.a0 + (size_t)128 * D * 2;
        q.b0 = (const char*)(ws + WS_WO) + (size_t)u.pn * 256 * D * 2; q.b1 = q.b0 + (size_t)128 * D * 2; }
    __device__ __forceinline__ void epi(const f32x4 (&acc)[2][2][4][2], const pg8::Unit& u, int wr, int wc, int fr, int fq) const {
        const int row0 = u.pm * 256 + wr * 64 + fr, col0 = u.pn * 256 + wc * 32 + 4 * fq;
        const float* xb = (u.pm < 64) ? xp + (size_t)row0 * D : xs + (size_t)(row0 - NPT) * D;
        float* ob = out + (size_t)row0 * D;
#pragma unroll
        for (int ai = 0; ai < 2; ++ai)
#pragma unroll
            for (int m = 0; m < 4; ++m) { const size_t ro = (size_t)(ai * 128 + m * 16) * D + col0;
#pragma unroll
                for (int bj = 0; bj < 2; ++bj)
#pragma unroll
                    for (int n = 0; n < 2; ++n) { const f32x4 xv = *(const f32x4*)(xb + ro + bj * 128 + n * 16); *(f32x4*)(ob + ro + bj * 128 + n * 16) = acc[ai][bj][m][n] + xv; } }
    }
};

__device__ __forceinline__ unsigned f2bf(float f) { unsigned u = __builtin_bit_cast(unsigned, f); return (u + 0x7fffu + ((u >> 16) & 1u)) >> 16; }
__device__ __forceinline__ unsigned pk2(float lo, float hi) { return f2bf(lo) | (f2bf(hi) << 16); }
__device__ __forceinline__ void p0_transpose_item(const float* W, int K, int N, bf16_t* WT, LAS float* scr, int item, int lane) {
    const int nblk = N / 32, kb = item / nblk, nb = item % nblk, k0 = 64 * kb, n0 = 32 * nb;
#pragma unroll 8
    for (int i = 0; i < 32; ++i) { const int kk = 2 * i + (lane >> 5); scr[kk * 33 + (lane & 31)] = W[(size_t)(k0 + kk) * N + n0 + (lane & 31)]; }
    LDS_WAIT(); asm volatile("" ::: "memory");
    const int c = lane & 7;
#pragma unroll
    for (int j = 0; j < 4; ++j) { const int n = (lane >> 3) + 8 * j; const LAS float* s = scr + (8 * c) * 33 + n;
        u32x4 o; o.x = pk2(s[0 * 33], s[1 * 33]); o.y = pk2(s[2 * 33], s[3 * 33]); o.z = pk2(s[4 * 33], s[5 * 33]); o.w = pk2(s[6 * 33], s[7 * 33]);
        *(u32x4*)(WT + (size_t)(n0 + n) * K + k0 + 8 * c) = o; }
    LDS_WAIT(); asm volatile("" ::: "memory");
}
template <bool OUT_BF16> __device__ __forceinline__ void rms_row(const float* xrow, const float* g, void* orow, int lane) {
    const f32x4* xr = (const f32x4*)xrow + lane;
    f32x4 v[16]; float s = 0.f;
#pragma unroll
    for (int j = 0; j < 16; ++j) { v[j] = xr[64 * j]; s += (v[j].x * v[j].x + v[j].y * v[j].y) + (v[j].z * v[j].z + v[j].w * v[j].w); }
    const float rstd = 1.0f / sqrtf(wave_sum(s) * (1.f / D) + EPS);
    const f32x4* gr = (const f32x4*)g + lane;
#pragma unroll
    for (int j = 0; j < 16; ++j) { const f32x4 gv = gr[64 * j]; const f32x4 y = v[j] * rstd * gv;
        if (OUT_BF16) { u32x2 w; w.x = cvt_pk_bf16(y.x, y.y); w.y = cvt_pk_bf16(y.z, y.w); ((u32x2*)orow)[lane + 64 * j] = w; }
        else ((f32x4*)orow)[lane + 64 * j] = y; }
}

struct Args { const float* in[11]; float* out; unsigned char* ws; int ph_lo, ph_hi; };

__device__ __forceinline__ void gla_pair_info(int p, int& tok0, int& L, int& h) { h = p & 31; if (p < 64) { tok0 = (p >> 5) * LP; L = LP; } else { tok0 = NPT + ((p - 64) >> 5) * LSQ; L = LSQ; } }

#if GLA_NAIVE
__device__ __forceinline__ void gla_pair_naive(LAS unsigned char* lds, unsigned char* ws, const float* ghead, int p) {
    const int tid = threadIdx.x, lane = tid & 63, wave = tid >> 6;
    int tok0, L, h; gla_pair_info(p, tok0, L, h);
    const bf16_t* Q = (const bf16_t*)(ws + WS_Q); bf16_t* KF = (bf16_t*)(ws + WS_KF); const bf16_t* KB = (const bf16_t*)(ws + WS_KB);
    const bf16_t* V = (const bf16_t*)(ws + WS_V); bf16_t* GA = (bf16_t*)(ws + WS_GA);
    LAS float* Lq = (LAS float*)lds; LAS float* Lf = Lq + 16 * 128; LAS float* Lk = Lf + 16 * 128; LAS float* Lv = Lk + 16 * 128; LAS float* Lo = Lv + 16 * 128;
    const int v = tid & 127, kq = tid >> 7;
    for (int pass = 0; pass < 2; ++pass) {
        float S[32];
#pragma unroll
        for (int i = 0; i < 32; ++i) S[i] = 0.f;
        const bf16_t* F = pass ? KB : (const bf16_t*)KF;
        for (int blk = 0; blk < L / 16; ++blk) {
            { const int i = tid >> 5, c4 = (tid & 31) * 4; const int tau = blk * 16 + i; const int t = tok0 + (pass ? (L - 1 - tau) : tau);
              const size_t off = (size_t)t * D + h * DH + c4;
              const u32x2 wq = *(const u32x2*)(Q + off), wf = *(const u32x2*)(F + off), wv = *(const u32x2*)(V + off);
              const float lf0 = bf_lo(wf.x), lf1 = bf_hi(wf.x), lf2 = bf_lo(wf.y), lf3 = bf_hi(wf.y);
              const float f0 = fexp(lf0), f1 = fexp(lf1), f2 = fexp(lf2), f3 = fexp(lf3);
              *(LAS f32x4*)(Lq + i * 128 + c4) = (f32x4){bf_lo(wq.x), bf_hi(wq.x), bf_lo(wq.y), bf_hi(wq.y)};
              *(LAS f32x4*)(Lf + i * 128 + c4) = (f32x4){f0, f1, f2, f3};
              *(LAS f32x4*)(Lk + i * 128 + c4) = (f32x4){1.f - f0, 1.f - f1, 1.f - f2, 1.f - f3};
              *(LAS f32x4*)(Lv + i * 128 + c4) = (f32x4){bf_lo(wv.x), bf_hi(wv.x), bf_lo(wv.y), bf_hi(wv.y)}; }
            __syncthreads();
            for (int i = 0; i < 16; ++i) {
                const float vv = Lv[i * 128 + v]; float op = 0.f;
#pragma unroll
                for (int k4 = 0; k4 < 8; ++k4) {
                    const f32x4 f = *(const LAS f32x4*)(Lf + i * 128 + kq * 32 + k4 * 4), kx = *(const LAS f32x4*)(Lk + i * 128 + kq * 32 + k4 * 4), qx = *(const LAS f32x4*)(Lq + i * 128 + kq * 32 + k4 * 4);
#pragma unroll
                    for (int e = 0; e < 4; ++e) { S[k4 * 4 + e] = f[e] * S[k4 * 4 + e] + kx[e] * vv; op += S[k4 * 4 + e] * qx[e]; }
                }
                Lo[(i * 4 + kq) * 128 + v] = op;
            }
            __syncthreads();
#pragma unroll
            for (int j = 0; j < 2; ++j) { const int i = 2 * wave + j; const int tau = blk * 16 + i; const int t = tok0 + (pass ? (L - 1 - tau) : tau);
                const size_t off = (size_t)t * D + h * DH + 2 * lane;
                float o0 = 0.f, o1 = 0.f;
#pragma unroll
                for (int q = 0; q < 4; ++q) { const f32x2 x = *(const LAS f32x2*)(Lo + (i * 4 + q) * 128 + 2 * lane); o0 += x.x; o1 += x.y; }
                if (pass == 0) { *(unsigned*)(KF + off) = cvt_pk_bf16(o0, o1); }
                else { const unsigned wf = *(const unsigned*)(KF + off), wg = *(const unsigned*)(GA + off);
                    o0 += bf_lo(wf); o1 += bf_hi(wf);
                    const float ss = wave_sum(o0 * o0 + o1 * o1); const float rstd = 1.0f / sqrtf(ss * (1.f / DH) + EPS);
                    const f32x2 gh = *(const f32x2*)(ghead + h * DH + 2 * lane);
                    *(unsigned*)(GA + off) = cvt_pk_bf16(o0 * rstd * gh.x * bf_lo(wg), o1 * rstd * gh.y * bf_hi(wg)); }
            }
            __syncthreads();
        }
        VM_WAIT(); __syncthreads(); __builtin_amdgcn_fence(__ATOMIC_ACQUIRE, "agent"); VM_WAIT(); __syncthreads();
    }
}
#endif

__device__ __forceinline__ void gla_phase(LAS unsigned char* lds, unsigned char* ws, const float* ghead, int vcu, int G) {
    if (G == 256) {
        if (vcu < 64) { gla_pair_naive(lds, ws, ghead, vcu); }
        else { gla_pair_naive(lds, ws, ghead, vcu); if (vcu < 128) gla_pair_naive(lds, ws, ghead, vcu + 192); }
    } else { for (int p = vcu; p < 320; p += G) gla_pair_naive(lds, ws, ghead, p); }
}

__global__ void __launch_bounds__(NWAVES * 64, 2) fwd_kernel(Args args) {
    extern __shared__ __attribute__((aligned(16))) unsigned char lds_raw[];
    LAS unsigned char* lds = (LAS unsigned char*)lds_raw;
    volatile LAS unsigned* MISC = (volatile LAS unsigned*)(lds + MISC_OFF);
    const int tid = threadIdx.x, lane = tid & 63, wave = __builtin_amdgcn_readfirstlane(tid >> 6);
    const int G = gridDim.x; const int bx = blockIdx.x; const int vcu = (G % 8 == 0) ? (bx % 8) * (G / 8) + bx / 8 : bx;
    unsigned char* ws = args.ws;
    unsigned* ctl = (unsigned*)(ws + WS_CTL);
    for (int u = tid; u < (LDS_BYTES - LDSCTL_OFF) / 4; u += NWAVES * 64) ((LAS unsigned*)(lds + LDSCTL_OFF))[u] = 0u;
    __syncthreads();
    XcdBarrier bar; bar.bar = ctl + CW_BAR; bar.x = 0; bar.st = nullptr;
    if (MK_N_LAUNCHES == 1) bar = xcd_barrier_post(ctl + CW_BAR, MISC + 8);
    const int lo = args.ph_lo, hi = args.ph_hi;
#define IN(k) (lo <= (k) && (k) < hi)
#define BOTH(k) (IN(k) && IN((k) + 1))
#define GRID_BAR() do { if (MK_N_LAUNCHES == 1) xcd_barrier(bar); } while (0)
    Ctx cx; cx.ws = ws; cx.xp = args.in[0]; cx.xs = args.in[1]; cx.out = args.out; cx.G = G; cx.c = bx;
    const int gw = vcu * NWAVES + wave, NGW = G * NWAVES;

    if (IN(0)) {
        LAS float* scr = (LAS float*)(lds + wave * 16384);
        const float* w_in = args.in[3]; const float* w_a = args.in[7]; const float* w_b = args.in[8]; const float* w_o = args.in[9];
        constexpr int I_IN = (D / 64) * (32768 / 32), I_A = (D / 64) * (D / 32), I_B = (DB / 64) * (D / 32), I_O = I_A;
        for (int it = gw; it < I_IN + I_A + I_B + I_O; it += NGW) {
            int r = it;
            if (r < I_IN) { p0_transpose_item(w_in, D, 32768, (bf16_t*)(ws + WS_WIN), scr, r, lane); continue; } r -= I_IN;
            if (r < I_A) { p0_transpose_item(w_a, D, D, (bf16_t*)(ws + WS_WA), scr, r, lane); continue; } r -= I_A;
            if (r < I_B) { p0_transpose_item(w_b, DB, D, (bf16_t*)(ws + WS_WB), scr, r, lane); continue; } r -= I_B;
            p0_transpose_item(w_o, D, D, (bf16_t*)(ws + WS_WO), scr, r, lane);
        }
        for (int m = gw; m < TOK; m += NGW) { const float* xr = (m < NPT) ? args.in[0] + (size_t)m * D : args.in[1] + (size_t)(m - NPT) * D;
            rms_row<true>(xr, args.in[2], (bf16_t*)(ws + WS_H) + (size_t)m * D, lane); }
        for (int i = bx * 512 + tid; i < 2 * D; i += G * 512) { const float* lbp = (i < D) ? args.in[4] : args.in[5]; const int c = i & (D - 1);
            const float a0 = lbp[c], a1 = lbp[D + c]; ((float*)(ws + (i < D ? WS_LBF : WS_LBB)))[c] = 1.0f / (1.0f + expf(a1 - a0)); }
        for (int i = bx * 512 + tid; i < 1024 * 512; i += G * 512) { const int r = i >> 9, c = i & 511, j = r & 511, part = r >> 9; const float ph = (float)((j * c) & 511) * (1.f / 512.f);
            const float vv = (part ? __builtin_amdgcn_sinf(ph) : __builtin_amdgcn_cosf(ph)) * 0.04419417382415922f; ((bf16_t*)(ws + WS_DFTC))[i] = (bf16_t)f2bf(vv); }
        if (BOTH(0)) GRID_BAR();
    }
    if (IN(1)) { ProbG1a P; P.init(cx); pg8::gemm_phase(lds, P); if (BOTH(1)) GRID_BAR(); }
    if (IN(2)) { gla_phase(lds, ws, args.in[6], vcu, G); if (BOTH(2)) GRID_BAR(); }
    if (IN(3)) {
        { ProbPlain P; P.init(cx, ws + WS_GA, ws + WS_WA, ws + WS_PA, D, D); pg8::gemm_phase(lds, P); }
        { ProbG1b P; P.init(cx); pg8::gemm_phase(lds, P); }
        for (size_t i = ((size_t)bx * 512 + tid) * 2; i < (size_t)LP * 2 * LP; i += (size_t)G * 1024) { const int lp = (int)(i >> 14), kk = (int)(i & 16383), part = kk >> 13, l = kk & 8191;
            const float p0 = (float)((lp * l) & 8191) * (1.f / 8192.f), p1 = (float)((lp * (l + 1)) & 8191) * (1.f / 8192.f); const float sc = 0.011048543456039806f;
            const float v0 = part ? -__builtin_amdgcn_sinf(p0) : __builtin_amdgcn_cosf(p0), v1 = part ? -__builtin_amdgcn_sinf(p1) : __builtin_amdgcn_cosf(p1);
            *(unsigned*)((bf16_t*)(ws + WS_DFTS8) + i) = cvt_pk_bf16(v0 * sc, v1 * sc); }
        for (size_t i = ((size_t)bx * 512 + tid) * 2; i < (size_t)LSQ * 2 * LSQ; i += (size_t)G * 1024) { const int lp = (int)(i >> 12), kk = (int)(i & 4095), part = kk >> 11, l = kk & 2047;
            const float p0 = (float)((lp * l) & 2047) * (1.f / 2048.f), p1 = (float)((lp * (l + 1)) & 2047) * (1.f / 2048.f); const float sc = 0.022097086912079608f;
            const float v0 = part ? -__builtin_amdgcn_sinf(p0) : __builtin_amdgcn_cosf(p0), v1 = part ? -__builtin_amdgcn_sinf(p1) : __builtin_amdgcn_cosf(p1);
            *(unsigned*)((bf16_t*)(ws + WS_DFTS2) + i) = cvt_pk_bf16(v0 * sc, v1 * sc); }
        if (BOTH(3)) GRID_BAR();
    }
    if (IN(4)) { ProbDft1 P; P.init(cx); pg8::gemm_phase(lds, P); if (BOTH(4)) GRID_BAR(); }
    if (IN(5)) { { ProbDft2 P; P.init(cx, 0); pg8::gemm_phase(lds, P); } { ProbDft2 P; P.init(cx, 1); pg8::gemm_phase(lds, P); } if (BOTH(5)) GRID_BAR(); }
    if (IN(6)) { ProbPlain P; P.init(cx, ws + WS_BOUT, ws + WS_WB, ws + WS_PB, D, DB); pg8::gemm_phase(lds, P); if (BOTH(6)) GRID_BAR(); }
    if (IN(7)) { ProbMerge P; P.init(cx); pg8::gemm_phase(lds, P); if (BOTH(7)) GRID_BAR(); }
    if (IN(8)) { ProbOut P; P.init(cx); pg8::gemm_phase(lds, P); if (BOTH(8)) GRID_BAR(); }
    if (IN(9)) { for (int m = gw; m < TOK; m += NGW) rms_row<false>(args.out + (size_t)m * D, args.in[10], args.out + (size_t)m * D, lane); }
#undef IN
#undef BOTH
#undef GRID_BAR
}

extern "C" void kernel_launch(void* const* d_in, const int* in_sizes, int n_in, void* d_out, int out_size, void* d_ws, size_t ws_size, hipStream_t stream) {
    static int grid = 0;
    if (grid == 0) {
        if (n_in != 11 || ws_size < WS_END) { fprintf(stderr, "kernel_launch: need 11 inputs and >= %zu bytes of workspace (got %d, %zu)\n", (size_t)WS_END, n_in, ws_size); grid = -1; return; }
        int dev = 0, cus = 0;
        if (hipGetDevice(&dev) != hipSuccess || hipDeviceGetAttribute(&cus, hipDeviceAttributeMultiprocessorCount, dev) != hipSuccess) { grid = -1; return; }
        if (hipFuncSetAttribute((const void*)fwd_kernel, hipFuncAttributeMaxDynamicSharedMemorySize, LDS_BYTES) != hipSuccess) { fprintf(stderr, "kernel_launch: hipFuncSetAttribute failed\n"); grid = -1; return; }
        int per_cu = 0;
        if (hipOccupancyMaxActiveBlocksPerMultiprocessor(&per_cu, (const void*)fwd_kernel, NWAVES * 64, LDS_BYTES) != hipSuccess || per_cu < 1) fprintf(stderr, "kernel_launch: occupancy query reports %d\n", per_cu);
        (void)hipGetLastError();
        grid = cus;
    }
    if (grid < 0) return;
    (void)hipMemsetAsync((char*)d_ws + WS_CTL, 0, CTL_ZERO_BYTES, stream);
    Args a{};
    for (int i = 0; i < 11; ++i) a.in[i] = (const float*)d_in[i];
    a.out = (float*)d_out; a.ws = (unsigned char*)d_ws;
    if (MK_N_LAUNCHES == 1) { a.ph_lo = 0; a.ph_hi = N_PHASES; hipLaunchKernelGGL(fwd_kernel, dim3(grid), dim3(NWAVES * 64), LDS_BYTES, stream, a); }
    else for (int li = 0; li < N_PHASES; ++li) { a.ph_lo = li; a.ph_hi = li + 1; hipLaunchKernelGGL(fwd_kernel, dim3(grid), dim3(NWAVES * 64), LDS_BYTES, stream, a); }
}
```

```cpp
#include <hip/hip_runtime.h>
#include <cstdio>
#include <cstdint>

#define LAS __attribute__((address_space(3)))
#define GAS __attribute__((address_space(1)))
typedef unsigned short bf16_t;
typedef short bf16x8 __attribute__((ext_vector_type(8)));
typedef short bf16x4 __attribute__((ext_vector_type(4)));
typedef float f32x2 __attribute__((ext_vector_type(2)));
typedef float f32x4 __attribute__((ext_vector_type(4)));
typedef float f32x16 __attribute__((ext_vector_type(16)));
typedef unsigned u32x2 __attribute__((ext_vector_type(2)));
typedef unsigned u32x4 __attribute__((ext_vector_type(4)));

#ifndef MK_N_LAUNCHES
#define MK_N_LAUNCHES 1
#endif
#ifndef GLA_NAIVE
#define GLA_NAIVE 0
#endif

constexpr int D = 4096, TOK = 32768, NPT = 16384, LP = 8192, LSQ = 2048, NH = 32, DH = 128, DB = 2048, CG = 512;
constexpr int C_U = 20480, C_MA = 24576, C_MB = 28672;
constexpr float EPS = 1e-6f;
constexpr int N_PHASES = 10;

constexpr size_t MiB = 1u << 20;
constexpr size_t WS_CTL = 0, CTL_ZERO_BYTES = 1 * MiB;
constexpr size_t WS_LBF = 1 * MiB, WS_LBB = 1 * MiB + 16384;
constexpr size_t WS_WIN = 2 * MiB, WS_WA = 258 * MiB, WS_WB = 290 * MiB, WS_WO = 306 * MiB, WS_H = 338 * MiB;
constexpr size_t WS_Q = 594 * MiB, WS_KF = 850 * MiB, WS_KB = 1106 * MiB, WS_V = 1362 * MiB, WS_GA = 1618 * MiB;
constexpr size_t WS_DFTC = 1874 * MiB, WS_DFTS2 = 1876 * MiB, WS_BOUT = 1892 * MiB, WS_END = 2020 * MiB;
constexpr size_t WS_PA = WS_Q, WS_U = WS_KF, WS_SGB = WS_KF + 128 * MiB, WS_M = WS_KF, WS_ABT = WS_KB, WS_DFTS8 = WS_V, WS_PB = WS_GA;
constexpr size_t ABT_SAMPLE_OFF = (size_t)2 * 2048 * 16384;
constexpr int CW_TMO = 0, CW_BAR = 4096;

constexpr int RING_BYTES = 131072;
constexpr int LDSCTL_OFF = RING_BYTES, MISC_OFF = LDSCTL_OFF + 320;
constexpr int LDS_BYTES = 147456;
constexpr int NWAVES = 8;

typedef __bf16 bf16x2_t __attribute__((ext_vector_type(2)));
__device__ __forceinline__ unsigned cvt_pk_bf16(float lo, float hi) { f32x2 v = {lo, hi}; bf16x2_t b = __builtin_convertvector(v, bf16x2_t); return __builtin_bit_cast(unsigned, b); }
__device__ __forceinline__ float bf_lo(unsigned w) { return __uint_as_float(w << 16); }
__device__ __forceinline__ float bf_hi(unsigned w) { return __uint_as_float(w & 0xffff0000u); }
__device__ __forceinline__ float fexp(float x) { return __builtin_amdgcn_exp2f(x * 1.44269504089f); }
__device__ __forceinline__ float frcp(float x) { return __builtin_amdgcn_rcpf(x); }
__device__ __forceinline__ float fsig(float x) { return frcp(1.f + fexp(-x)); }
__device__ __forceinline__ float fsilu(float x) { return x * fsig(x); }
__device__ __forceinline__ float flog(float x) { return __builtin_amdgcn_logf(x) * 0.69314718056f; }
__device__ __forceinline__ float wave_sum(float v) {
#pragma unroll
    for (int o = 1; o < 64; o <<= 1) v += __shfl_xor(v, o);
    return v;
}
#define LDS_WAIT() asm volatile("s_waitcnt lgkmcnt(0)" ::: "memory")
#define VM_WAIT() asm volatile("s_waitcnt vmcnt(0)" ::: "memory")

namespace pg8 {
constexpr int BM = 256, BK = 64, HALF = 128, HTB = HALF * BK * 2, STAGE_BYTES = 8 * HTB, NXCD = 8, WGM = 8;
__host__ __device__ __forceinline__ int lds_byte(int r, int c) { const int st = (r >> 4) * 2 + (c >> 5), rr = r & 15, cc = c & 31, ob = rr * 64 + cc * 2; return st * 1024 + (ob ^ (((ob >> 9) & 1) << 5)); }
__host__ __device__ __forceinline__ void stage_rc(int b, int& R, int& C) { const int st = b / 1024, sb = b % 1024, swz = sb ^ (((sb >> 9) & 1) << 5); R = (st >> 1) * 16 + swz / 64; C = (st & 1) * 32 + (swz % 64) / 2; }
__host__ __device__ __forceinline__ int perm32(int rho) { const int n = rho >> 4, i = rho & 15; return 8 * (i >> 2) + 4 * n + (i & 3); }

struct Unit { int pm, pn; };
struct Ptrs { const char* a0; const char* a1; const char* b0; const char* b1; };

struct StaticOrder {
    int nM, nN, nwg, G, c;
    __host__ __device__ void init(int M, int N, int G_, int c_) { nM = M / BM; nN = N / BM; nwg = nM * nN; G = G_; c = c_; }
    __host__ __device__ bool next(int i, Unit& u) const {
        const long L = (long)i * G + c; if (L >= nwg) return false;
        int wgid = (int)L; { const int q = nwg / NXCD, r = nwg % NXCD, xcd = wgid % NXCD, off = wgid / NXCD; wgid = (xcd < r ? xcd * (q + 1) : r * (q + 1) + (xcd - r) * q) + off; }
        const int nig = WGM * nN, gid = wgid / nig, fm = gid * WGM, gsz = (nM - fm) < WGM ? (nM - fm) : WGM;
        u.pm = fm + ((wgid % nig) % gsz); u.pn = (wgid % nig) / gsz; return true;
    }
};

template <class P>
__device__ __forceinline__ void gemm_phase(LAS unsigned char* lds, const P& p) {
    const int tid = threadIdx.x, wid = __builtin_amdgcn_readfirstlane(tid >> 6), lane = tid & 63, wr = wid >> 2, wc = wid & 3, fr = lane & 15, fq = lane >> 4;
    const int nt = p.nt;
    unsigned voffA[2], voffB[2];
#pragma unroll
    for (int i = 0; i < 2; ++i) { int R, C; stage_rc(tid * 16 + i * 8192, R, C); const int Rb = P::PERM ? ((R & ~31) + perm32(R & 31)) : R;
        voffA[i] = (unsigned)(R * p.lda + C) * 2u; voffB[i] = (unsigned)(Rb * p.ldb + C) * 2u; }
    const size_t kstep = (size_t)(BK * 2);
    const unsigned ldsw = (unsigned)wid * 1024u;
    const int aoff = lds_byte(wr * 64 + fr, fq * 8), boff = lds_byte(wc * 32 + fr, fq * 8);
#define PG8_SA(b, h) (((b) * 2 + (h)) * HTB)
#define PG8_SB(b, h) ((4 + (b) * 2 + (h)) * HTB)
#define PG8_STAGE(bufoff, gbase, voff) do { _Pragma("unroll") for (int _i = 0; _i < 2; ++_i) \
        __builtin_amdgcn_global_load_lds((const unsigned*)((const char*)(gbase) + (voff)[_i]), (LAS unsigned*)(lds + (bufoff) + ldsw + _i * 8192), 16, 0, 0); } while (0)
#define PG8_LDA(dst, b, h) do { _Pragma("unroll") for (int m = 0; m < 4; ++m) _Pragma("unroll") for (int k = 0; k < 2; ++k) dst[m][k] = *(const LAS bf16x8*)(lds + PG8_SA(b, h) + aoff + m * 2048 + k * 1024); } while (0)
#define PG8_LDB(dst, b, h) do { _Pragma("unroll") for (int n = 0; n < 2; ++n) _Pragma("unroll") for (int k = 0; k < 2; ++k) dst[n][k] = *(const LAS bf16x8*)(lds + PG8_SB(b, h) + boff + n * 2048 + k * 1024); } while (0)
#define PG8_MMA(ai, bj, At, Bt) do { __builtin_amdgcn_s_setprio(1); _Pragma("unroll") for (int m = 0; m < 4; ++m) _Pragma("unroll") for (int n = 0; n < 2; ++n) _Pragma("unroll") for (int k = 0; k < 2; ++k) \
        acc[ai][bj][m][n] = __builtin_amdgcn_mfma_f32_16x16x32_bf16(Bt[n][k], At[m][k], acc[ai][bj][m][n], 0, 0, 0); __builtin_amdgcn_s_setprio(0); } while (0)
#define PG8_WAIT_V(n) asm volatile("s_waitcnt vmcnt(" #n ")" ::: "memory")
#define PG8_WAIT_L(n) asm volatile("s_waitcnt lgkmcnt(" #n ")" ::: "memory")
#define PG8_BAR __builtin_amdgcn_s_barrier()
#define PG8_SCHED __builtin_amdgcn_sched_barrier(0)
    Unit cur, nxt; int ui = 0;
    if (!p.next(0, cur)) return;
    f32x4 acc[2][2][4][2];
#pragma unroll
    for (int a = 0; a < 2; ++a)
#pragma unroll
        for (int b = 0; b < 2; ++b)
#pragma unroll
            for (int m = 0; m < 4; ++m)
#pragma unroll
                for (int n = 0; n < 2; ++n) acc[a][b][m][n] = (f32x4){0.f, 0.f, 0.f, 0.f};
    bf16x8 At[4][2], B0[2][2], B1[2][2];
    Ptrs cq; p.ptrs(cur, cq);
    PG8_STAGE(PG8_SB(0, 0), cq.b0, voffB); PG8_STAGE(PG8_SB(0, 1), cq.b1, voffB); PG8_STAGE(PG8_SA(0, 0), cq.a0, voffA); PG8_STAGE(PG8_SA(0, 1), cq.a1, voffA);
    if (wr == 1) PG8_BAR;
    PG8_WAIT_V(2); PG8_BAR;
    PG8_STAGE(PG8_SB(1, 0), cq.b0 + kstep, voffB); PG8_STAGE(PG8_SA(1, 0), cq.a0 + kstep, voffA); PG8_STAGE(PG8_SB(1, 1), cq.b1 + kstep, voffB);
    PG8_WAIT_V(6); PG8_BAR;
    for (;;) {
        const bool has_next = p.next(ui + 1, nxt);
        Ptrs nq = cq; if (has_next) p.ptrs(nxt, nq);
        for (int t = 0; t < nt; t += 2) {
            const bool last = (t == nt - 2);
            const size_t o1 = (size_t)(t + 1) * kstep, o2 = (size_t)(t + 2) * kstep;
            const char* a1_1 = cq.a1 + o1;
            const char* a2_0 = last ? nq.a0 : cq.a0 + o2; const char* a2_1 = last ? nq.a1 : cq.a1 + o2;
            const char* b2_0 = last ? nq.b0 : cq.b0 + o2; const char* b2_1 = last ? nq.b1 : cq.b1 + o2;
            PG8_LDB(B0, 0, 0); PG8_LDB(B1, 0, 1); PG8_SCHED; PG8_LDA(At, 0, 0); PG8_STAGE(PG8_SA(1, 1), a1_1, voffA);
            PG8_WAIT_V(8); PG8_WAIT_L(0); PG8_BAR; PG8_MMA(0, 0, At, B0); PG8_MMA(0, 1, At, B1); PG8_BAR; PG8_SCHED;
            PG8_LDA(At, 0, 1); PG8_STAGE(PG8_SB(0, 0), b2_0, voffB); PG8_STAGE(PG8_SB(0, 1), b2_1, voffB); PG8_STAGE(PG8_SA(0, 0), a2_0, voffA);
            PG8_WAIT_V(8); PG8_WAIT_L(0); PG8_BAR; PG8_MMA(1, 0, At, B0); PG8_MMA(1, 1, At, B1); PG8_BAR; PG8_SCHED;
            PG8_LDB(B0, 1, 0); PG8_LDB(B1, 1, 1); PG8_SCHED; PG8_LDA(At, 1, 0); PG8_STAGE(PG8_SA(0, 1), a2_1, voffA);
            PG8_WAIT_V(8); PG8_WAIT_L(0); PG8_BAR; PG8_MMA(0, 0, At, B0); PG8_MMA(0, 1, At, B1); PG8_BAR; PG8_SCHED;
            PG8_LDA(At, 1, 1); PG8_STAGE(PG8_SB(1, 0), b2_0 + kstep, voffB); PG8_STAGE(PG8_SB(1, 1), b2_1 + kstep, voffB); PG8_STAGE(PG8_SA(1, 0), a2_0 + kstep, voffA);
            PG8_WAIT_V(8); PG8_WAIT_L(0); PG8_BAR; PG8_MMA(1, 0, At, B0); PG8_MMA(1, 1, At, B1); PG8_BAR; PG8_SCHED;
        }
        if (wr == 0) PG8_BAR;
        p.epi(acc, cur, wr, wc, fr, fq);
        if (!has_next) break;
#pragma unroll
        for (int a = 0; a < 2; ++a)
#pragma unroll
            for (int b = 0; b < 2; ++b)
#pragma unroll
                for (int m = 0; m < 4; ++m)
#pragma unroll
                    for (int n = 0; n < 2; ++n) acc[a][b][m][n] = (f32x4){0.f, 0.f, 0.f, 0.f};
        cur = nxt; cq = nq; ++ui;
        if (wr == 1) PG8_BAR;
    }
    PG8_WAIT_V(0);
    PG8_BAR;
#undef PG8_SA
#undef PG8_SB
#undef PG8_STAGE
#undef PG8_LDA
#undef PG8_LDB
#undef PG8_MMA
#undef PG8_WAIT_V
#undef PG8_WAIT_L
#undef PG8_BAR
#undef PG8_SCHED
}
}

#define XB_TMO      128
#define XB_XCNT(j)  (256  + 64 * (j))
#define XB_XSUB(j)  (1280 + 64 * (j))
#define XB_XGEN(j)  (2304 + 64 * (j))
#define XB_TOP      3328
#define XB_TOPGEN   3392
#define XCD_BAR_WORDS 3456
#define XB_SPIN_CAP (1u << 18)
__device__ __forceinline__ unsigned xb_ld(unsigned* p)              { return __hip_atomic_load(p, __ATOMIC_RELAXED, __HIP_MEMORY_SCOPE_AGENT); }
__device__ __forceinline__ unsigned xb_add(unsigned* p, unsigned v) { return __hip_atomic_fetch_add(p, v, __ATOMIC_RELAXED, __HIP_MEMORY_SCOPE_AGENT); }
__device__ __forceinline__ unsigned xb_xcc_id() { return (unsigned)__builtin_amdgcn_s_getreg((3 << 11) | 20) & 0xFu; }
#define XB_SPIN(cond, bar) do { unsigned _sp = 0; while (cond) { __builtin_amdgcn_s_sleep(1); \
    if ((++_sp & 255u) == 0u) { if (xb_ld(&(bar)[XB_TMO])) break; if (_sp > XB_SPIN_CAP) { atomicAdd(&(bar)[XB_TMO], 1u); break; } } } } while (0)
struct XcdBarrier { unsigned* bar; unsigned x; volatile LAS unsigned* st; };
__device__ __forceinline__ XcdBarrier xcd_barrier_post(unsigned* bar, volatile LAS unsigned* st) {
    XcdBarrier b; b.bar = bar; b.x = xb_xcc_id(); b.st = st;
    if (threadIdx.x == 0) (void)xb_add(&bar[XB_XCNT(b.x)], 1u);
    return b;
}
__device__ __forceinline__ void xcd_barrier_complete(unsigned* bar, unsigned x, unsigned& nloc, unsigned& nx) {
    const unsigned G = gridDim.x * gridDim.y * gridDim.z;
    unsigned sum, cnt, mine, sp = 0u;
    for (;;) {
        sum = 0u; cnt = 0u; mine = 0u;
#pragma unroll
        for (unsigned j = 0; j < 16; ++j) { const unsigned c = xb_ld(&bar[XB_XCNT(j)]); sum += c; cnt += (c > 0u) ? 1u : 0u; mine = (j == x) ? c : mine; }
        if (sum == G) break;
        __builtin_amdgcn_s_sleep(1);
        if ((++sp & 255u) == 0u) { if (xb_ld(&bar[XB_TMO])) break; if (sp > XB_SPIN_CAP) { atomicAdd(&bar[XB_TMO], 1u); break; } }
    }
    nloc = mine > 0u ? mine : 1u; nx = cnt > 0u ? cnt : 1u;
}
__device__ __forceinline__ void xcd_barrier(const XcdBarrier& b) {
    asm volatile("s_waitcnt vmcnt(0)" ::: "memory");
    __syncthreads();
    if (threadIdx.x == 0) {
        unsigned* bar = b.bar;
        __builtin_amdgcn_s_waitcnt(0);
        unsigned nloc = b.st[0], nx = b.st[1];
        if (nloc == 0u) { xcd_barrier_complete(bar, b.x, nloc, nx); b.st[0] = nloc; b.st[1] = nx; }
        const unsigned old = xb_add(&bar[XB_XSUB(b.x)], 1u);
        const unsigned gen = old / nloc;
        if (old + 1u == (gen + 1u) * nloc) {
            __builtin_amdgcn_fence(__ATOMIC_RELEASE, "agent");
            asm volatile("s_waitcnt vmcnt(0)" ::: "memory");
            const unsigned og = xb_add(&bar[XB_TOP], 1u);
            const unsigned tg = og / nx;
            if (og + 1u == (tg + 1u) * nx) xb_add(&bar[XB_TOPGEN], 1u);
            else XB_SPIN(xb_ld(&bar[XB_TOPGEN]) == tg, bar);
            __builtin_amdgcn_fence(__ATOMIC_ACQUIRE, "agent");
            xb_add(&bar[XB_XGEN(b.x)], 1u);
            asm volatile("s_waitcnt vmcnt(0)" ::: "memory");
        } else {
            XB_SPIN(xb_ld(&bar[XB_XGEN(b.x)]) == gen, bar);
            __builtin_amdgcn_fence(__ATOMIC_ACQUIRE, "agent");
            asm volatile("s_waitcnt vmcnt(0)" ::: "memory");
        }
    }
    __syncthreads();
}

struct Ctx { unsigned char* ws; const float* xp; const float* xs; float* out; int G, c; };

template <class F> __device__ __forceinline__ void epi_store_bf16(const f32x4 (&acc)[2][2][4][2], bf16_t* tile  , size_t ldc, const F& f) {
#pragma unroll
    for (int ai = 0; ai < 2; ++ai)
#pragma unroll
        for (int m = 0; m < 4; ++m) { bf16_t* rowp = tile + (size_t)(ai * 128 + m * 16) * ldc;
#pragma unroll
            for (int bj = 0; bj < 2; ++bj) { f32x4 v0 = acc[ai][bj][m][0], v1 = acc[ai][bj][m][1];
                f(v0, v1, bj, ai * 128 + m * 16);
                u32x4 w; w.x = cvt_pk_bf16(v0[0], v0[1]); w.y = cvt_pk_bf16(v0[2], v0[3]); w.z = cvt_pk_bf16(v1[0], v1[1]); w.w = cvt_pk_bf16(v1[2], v1[3]);
                *(u32x4*)(rowp + bj * 128) = w; } }
}
struct FIdent { __device__ __forceinline__ void operator()(f32x4&, f32x4&, int, int) const {} };
struct FSilu { float s; __device__ __forceinline__ void operator()(f32x4& a, f32x4& b, int, int) const {
#pragma unroll
    for (int e = 0; e < 4; ++e) { a[e] = fsilu(a[e]) * s; b[e] = fsilu(b[e]) * s; } } };
struct FLogF { f32x4 lb[2][2]; __device__ __forceinline__ void operator()(f32x4& a, f32x4& b, int bj, int) const {
#pragma unroll
    for (int e = 0; e < 4; ++e) { const float l0 = lb[bj][0][e], l1 = lb[bj][1][e];
        a[e] = flog(l0 + (1.f - l0) * fsig(a[e])); b[e] = flog(l1 + (1.f - l1) * fsig(b[e])); } } };

struct ProbG1a {
    static constexpr bool PERM = true;
    pg8::StaticOrder S; int lda, ldb, nt; unsigned char* ws;
    __device__ __forceinline__ void init(const Ctx& c) { S.init(TOK, 20480, c.G, c.c); lda = D; ldb = D; nt = D / 64; ws = c.ws; }
    __device__ __forceinline__ bool next(int i, pg8::Unit& u) const { return S.next(i, u); }
    __device__ __forceinline__ void ptrs(const pg8::Unit& u, pg8::Ptrs& q) const {
        q.a0 = (const char*)(ws + WS_H) + (size_t)u.pm * 256 * D * 2; q.a1 = q.a0 + (size_t)128 * D * 2;
        q.b0 = (const char*)(ws + WS_WIN) + (size_t)u.pn * 256 * D * 2; q.b1 = q.b0 + (size_t)128 * D * 2; }
    __device__ __forceinline__ void epi(const f32x4 (&acc)[2][2][4][2], const pg8::Unit& u, int wr, int wc, int fr, int fq) const {
        const int seg = u.pn >> 4, colt = (u.pn & 15) * 256 + wc * 32 + 8 * fq, row0 = u.pm * 256 + wr * 64 + fr;
        bf16_t* tile = (bf16_t*)(ws + WS_Q + (size_t)seg * 256 * MiB) + (size_t)row0 * D + colt;
        if (seg == 0) { FSilu f{0.08838834764831845f}; epi_store_bf16(acc, tile, D, f); }
        else if (seg == 1 || seg == 2) { const float* lb = (const float*)(ws + (seg == 1 ? WS_LBF : WS_LBB)) + colt; FLogF f;
#pragma unroll
            for (int bj = 0; bj < 2; ++bj)
#pragma unroll
                for (int n = 0; n < 2; ++n) f.lb[bj][n] = *(const f32x4*)(lb + bj * 128 + 4 * n);
            epi_store_bf16(acc, tile, D, f); }
        else if (seg == 3) { FIdent f; epi_store_bf16(acc, tile, D, f); }
        else { FSilu f{1.f}; epi_store_bf16(acc, tile, D, f); }
    }
};
struct ProbPlain {
    static constexpr bool PERM = true;
    pg8::StaticOrder S; int lda, ldb, nt; const char* A; const char* B; bf16_t* C; int ldc;
    __device__ __forceinline__ void init(const Ctx& c, const void* A_, const void* B_, void* C_, int N, int K) { S.init(TOK, N, c.G, c.c); lda = K; ldb = K; nt = K / 64; A = (const char*)A_; B = (const char*)B_; C = (bf16_t*)C_; ldc = N; }
    __device__ __forceinline__ bool next(int i, pg8::Unit& u) const { return S.next(i, u); }
    __device__ __forceinline__ void ptrs(const pg8::Unit& u, pg8::Ptrs& q) const {
        q.a0 = A + (size_t)u.pm * 256 * lda * 2; q.a1 = q.a0 + (size_t)128 * lda * 2; q.b0 = B + (size_t)u.pn * 256 * ldb * 2; q.b1 = q.b0 + (size_t)128 * ldb * 2; }
    __device__ __forceinline__ void epi(const f32x4 (&acc)[2][2][4][2], const pg8::Unit& u, int wr, int wc, int fr, int fq) const {
        bf16_t* tile = C + (size_t)(u.pm * 256 + wr * 64 + fr) * ldc + u.pn * 256 + wc * 32 + 8 * fq; FIdent f; epi_store_bf16(acc, tile, ldc, f); }
};
struct ProbG1b {
    static constexpr bool PERM = true;
    pg8::StaticOrder S; int lda, ldb, nt; unsigned char* ws;
    __device__ __forceinline__ void init(const Ctx& c) { S.init(TOK, 4096, c.G, c.c); lda = D; ldb = D; nt = D / 64; ws = c.ws; }
    __device__ __forceinline__ bool next(int i, pg8::Unit& u) const { return S.next(i, u); }
    __device__ __forceinline__ void ptrs(const pg8::Unit& u, pg8::Ptrs& q) const {
        q.a0 = (const char*)(ws + WS_H) + (size_t)u.pm * 256 * D * 2; q.a1 = q.a0 + (size_t)128 * D * 2;
        q.b0 = (const char*)(ws + WS_WIN) + (size_t)(C_U + u.pn * 256) * D * 2; q.b1 = q.b0 + (size_t)128 * D * 2; }
    __device__ __forceinline__ void epi(const f32x4 (&acc)[2][2][4][2], const pg8::Unit& u, int wr, int wc, int fr, int fq) const {
        const int seg = u.pn >> 3, colt = (u.pn & 7) * 256 + wc * 32 + 8 * fq, row0 = u.pm * 256 + wr * 64 + fr;
        bf16_t* tile = (bf16_t*)(ws + (seg ? WS_SGB : WS_U)) + (size_t)row0 * DB + colt;
        if (seg == 0) { FIdent f; epi_store_bf16(acc, tile, DB, f); } else { FSilu f{1.f}; epi_store_bf16(acc, tile, DB, f); }
    }
};
struct ProbDft1 {
    static constexpr bool PERM = true;
    pg8::StaticOrder S; int lda, ldb, nt; unsigned char* ws;
    __device__ __forceinline__ void init(const Ctx& c) { S.init(4096, TOK, c.G, c.c); lda = CG; ldb = DB; nt = CG / 64; ws = c.ws; }
    __device__ __forceinline__ bool next(int i, pg8::Unit& u) const { return S.next(i, u); }
    __device__ __forceinline__ void ptrs(const pg8::Unit& u, pg8::Ptrs& q) const {
        const int g = u.pm >> 2, pmr = u.pm & 3;
        q.a0 = (const char*)(ws + WS_DFTC) + (size_t)pmr * 256 * CG * 2; q.a1 = q.a0 + (size_t)128 * CG * 2;
        q.b0 = (const char*)(ws + WS_U) + ((size_t)u.pn * 256 * DB + (size_t)g * CG) * 2; q.b1 = q.b0 + (size_t)128 * DB * 2; }
    __device__ __forceinline__ void epi(const f32x4 (&acc)[2][2][4][2], const pg8::Unit& u, int wr, int wc, int fr, int fq) const {
        const int g = u.pm >> 2, pmr = u.pm & 3, part = pmr >> 1, j0 = (pmr & 1) * 256 + wr * 64 + fr;
        const int tt = u.pn; size_t base; int L, l0;
        if (tt < 64) { L = LP; base = (size_t)(tt >> 5) * 2048 * (2 * LP); l0 = (tt & 31) * 256; }
        else { const int ts = tt - 64; L = LSQ; base = ABT_SAMPLE_OFF + (size_t)(ts >> 3) * 2048 * (2 * LSQ); l0 = (ts & 7) * 256; }
        bf16_t* tile = (bf16_t*)(ws + WS_ABT) + base + (size_t)(g * CG + j0) * (2 * L) + (size_t)part * L + l0 + wc * 32 + 8 * fq;
        FIdent f; epi_store_bf16(acc, tile, (size_t)2 * L, f);
    }
};
struct FMulG { const bf16_t* g; __device__ __forceinline__ void operator()(f32x4& a, f32x4& b, int bj, int roff) const {
    const u32x4 w = *(const u32x4*)(g + (size_t)roff * DB + bj * 128);
    a[0] *= bf_lo(w.x); a[1] *= bf_hi(w.x); a[2] *= bf_lo(w.y); a[3] *= bf_hi(w.y); b[0] *= bf_lo(w.z); b[1] *= bf_hi(w.z); b[2] *= bf_lo(w.w); b[3] *= bf_hi(w.w); } };
struct ProbDft2 {
    static constexpr bool PERM = true;
    pg8::StaticOrder S; int lda, ldb, nt; unsigned char* ws; int L, lshift; size_t abt_off, dfts_off; int tok0;
    __device__ __forceinline__ void init(const Ctx& c, int sample) { S.init(16384, DB, c.G, c.c); ws = c.ws;
        if (!sample) { L = LP; lshift = 5; abt_off = 0; dfts_off = WS_DFTS8; tok0 = 0; } else { L = LSQ; lshift = 3; abt_off = ABT_SAMPLE_OFF; dfts_off = WS_DFTS2; tok0 = NPT; }
        lda = 2 * L; ldb = 2 * L; nt = 2 * L / 64; }
    __device__ __forceinline__ bool next(int i, pg8::Unit& u) const { return S.next(i, u); }
    __device__ __forceinline__ void ptrs(const pg8::Unit& u, pg8::Ptrs& q) const {
        const int b = u.pm >> lshift, pml = u.pm & ((1 << lshift) - 1);
        q.a0 = (const char*)(ws + dfts_off) + (size_t)pml * 256 * (2 * L) * 2; q.a1 = q.a0 + (size_t)128 * (2 * L) * 2;
        q.b0 = (const char*)(ws + WS_ABT) + (abt_off + (size_t)b * 2048 * (2 * L) + (size_t)u.pn * 256 * (2 * L)) * 2; q.b1 = q.b0 + (size_t)128 * (2 * L) * 2; }
    __device__ __forceinline__ void epi(const f32x4 (&acc)[2][2][4][2], const pg8::Unit& u, int wr, int wc, int fr, int fq) const {
        const size_t off = (size_t)(tok0 + u.pm * 256 + wr * 64 + fr) * DB + u.pn * 256 + wc * 32 + 8 * fq;
        FMulG f{(const bf16_t*)(ws + WS_SGB) + off}; epi_store_bf16(acc, (bf16_t*)(ws + WS_BOUT) + off, DB, f);
    }
};
struct ProbMerge {
    static constexpr bool PERM = true;
    pg8::StaticOrder S; int lda, ldb, nt; unsigned char* ws;
    __device__ __forceinline__ void init(const Ctx& c) { S.init(TOK, 8192, c.G, c.c); lda = D; ldb = D; nt = D / 64; ws = c.ws; }
    __device__ __forceinline__ bool next(int i, pg8::Unit& u) const { return S.next(i, u); }
    __device__ __forceinline__ void ptrs(const pg8::Unit& u, pg8::Ptrs& q) const {
        q.a0 = (const char*)(ws + WS_H) + (size_t)u.pm * 256 * D * 2; q.a1 = q.a0 + (size_t)128 * D * 2;
        q.b0 = (const char*)(ws + WS_WIN) + (size_t)(C_MA + u.pn * 128) * D * 2; q.b1 = (const char*)(ws + WS_WIN) + (size_t)(C_MB + u.pn * 128) * D * 2; }
    __device__ __forceinline__ void epi(const f32x4 (&acc)[2][2][4][2], const pg8::Unit& u, int wr, int wc, int fr, int fq) const {
        const size_t off0 = (size_t)(u.pm * 256 + wr * 64 + fr) * D + u.pn * 128 + wc * 32 + 8 * fq;
        const bf16_t* pa = (const bf16_t*)(ws + WS_PA) + off0; const bf16_t* pb = (const bf16_t*)(ws + WS_PB) + off0; bf16_t* mo = (bf16_t*)(ws + WS_M) + off0;
#pragma unroll
        for (int ai = 0; ai < 2; ++ai)
#pragma unroll
            for (int m = 0; m < 4; ++m) { const size_t ro = (size_t)(ai * 128 + m * 16) * D;
                const u32x4 wa = *(const u32x4*)(pa + ro), wb = *(const u32x4*)(pb + ro);
                const f32x4 a0 = acc[ai][0][m][0], a1 = acc[ai][0][m][1], b0 = acc[ai][1][m][0], b1 = acc[ai][1][m][1];
                float r[8];
                r[0] = fsig(a0[0]) * bf_lo(wa.x) + fsig(b0[0]) * bf_lo(wb.x); r[1] = fsig(a0[1]) * bf_hi(wa.x) + fsig(b0[1]) * bf_hi(wb.x);
                r[2] = fsig(a0[2]) * bf_lo(wa.y) + fsig(b0[2]) * bf_lo(wb.y); r[3] = fsig(a0[3]) * bf_hi(wa.y) + fsig(b0[3]) * bf_hi(wb.y);
                r[4] = fsig(a1[0]) * bf_lo(wa.z) + fsig(b1[0]) * bf_lo(wb.z); r[5] = fsig(a1[1]) * bf_hi(wa.z) + fsig(b1[1]) * bf_hi(wb.z);
                r[6] = fsig(a1[2]) * bf_lo(wa.w) + fsig(b1[2]) * bf_lo(wb.w); r[7] = fsig(a1[3]) * bf_hi(wa.w) + fsig(b1[3]) * bf_hi(wb.w);
                u32x4 w; w.x = cvt_pk_bf16(r[0], r[1]); w.y = cvt_pk_bf16(r[2], r[3]); w.z = cvt_pk_bf16(r[4], r[5]); w.w = cvt_pk_bf16(r[6], r[7]);
                *(u32x4*)(mo + ro) = w; }
    }
};
struct ProbOut {
    static constexpr bool PERM = false;
    pg8::StaticOrder S; int lda, ldb, nt; unsigned char* ws; const float* xp; const float* xs; float* out;
    __device__ __forceinline__ void init(const Ctx& c) { S.init(TOK, D, c.G, c.c); lda = D; ldb = D; nt = D / 64; ws = c.ws; xp = c.xp; xs = c.xs; out = c.out; }
    __device__ __forceinline__ bool next(int i, pg8::Unit& u) const { return S.next(i, u); }
    __device__ __forceinline__ void ptrs(const pg8::Unit& u, pg8::Ptrs& q) const {
        q.a0 = (const char*)(ws + WS_M) + (size_t)u.pm * 256 * D * 2; q.a1 = q.a0 + (size_t)128 * D * 2;
        q.b0 = (const char*)(ws + WS_WO) + (size_t)u.pn * 256 * D * 2; q.b1 = q.b0 + (size_t)128 * D * 2; }
    __device__ __forceinline__ void epi(const f32x4 (&acc)[2][2][4][2], const pg8::Unit& u, int wr, int wc, int fr, int fq) const {
        const int row0 = u.pm * 256 + wr * 64 + fr, col0 = u.pn * 256 + wc * 32 + 4 * fq;
        const float* xb = (u.pm < 64) ? xp + (size_t)row0 * D : xs + (size_t)(row0 - NPT) * D;
        float* ob = out + (size_t)row0 * D;
#pragma unroll
        for (int ai = 0; ai < 2; ++ai)
#pragma unroll
            for (int m = 0; m < 4; ++m) { const size_t ro = (size_t)(ai * 128 + m * 16) * D + col0;
#pragma unroll
                for (int bj = 0; bj < 2; ++bj)
#pragma unroll
                    for (int n = 0; n < 2; ++n) { const f32x4 xv = *(const f32x4*)(xb + ro + bj * 128 + n * 16); *(f32x4*)(ob + ro + bj * 128 + n * 16) = acc[ai][bj][m][n] + xv; } }
    }
};

__device__ __forceinline__ unsigned f2bf(float f) { unsigned u = __builtin_bit_cast(unsigned, f); return (u + 0x7fffu + ((u >> 16) & 1u)) >> 16; }
__device__ __forceinline__ unsigned pk2(float lo, float hi) { return f2bf(lo) | (f2bf(hi) << 16); }
__device__ __forceinline__ void p0_transpose_item(const float* W, int K, int N, bf16_t* WT, LAS float* scr, int item, int lane) {
    const int nblk = N / 32, kb = item / nblk, nb = item % nblk, k0 = 64 * kb, n0 = 32 * nb;
#pragma unroll 8
    for (int i = 0; i < 32; ++i) { const int kk = 2 * i + (lane >> 5); scr[kk * 33 + (lane & 31)] = W[(size_t)(k0 + kk) * N + n0 + (lane & 31)]; }
    LDS_WAIT(); asm volatile("" ::: "memory");
    const int c = lane & 7;
#pragma unroll
    for (int j = 0; j < 4; ++j) { const int n = (lane >> 3) + 8 * j; const LAS float* s = scr + (8 * c) * 33 + n;
        u32x4 o; o.x = pk2(s[0 * 33], s[1 * 33]); o.y = pk2(s[2 * 33], s[3 * 33]); o.z = pk2(s[4 * 33], s[5 * 33]); o.w = pk2(s[6 * 33], s[7 * 33]);
        *(u32x4*)(WT + (size_t)(n0 + n) * K + k0 + 8 * c) = o; }
    LDS_WAIT(); asm volatile("" ::: "memory");
}
template <bool OUT_BF16> __device__ __forceinline__ void rms_row(const float* xrow, const float* g, void* orow, int lane) {
    const f32x4* xr = (const f32x4*)xrow + lane;
    f32x4 v[16]; float s = 0.f;
#pragma unroll
    for (int j = 0; j < 16; ++j) { v[j] = xr[64 * j]; s += (v[j].x * v[j].x + v[j].y * v[j].y) + (v[j].z * v[j].z + v[j].w * v[j].w); }
    const float rstd = 1.0f / sqrtf(wave_sum(s) * (1.f / D) + EPS);
    const f32x4* gr = (const f32x4*)g + lane;
#pragma unroll
    for (int j = 0; j < 16; ++j) { const f32x4 gv = gr[64 * j]; const f32x4 y = v[j] * rstd * gv;
        if (OUT_BF16) { u32x2 w; w.x = cvt_pk_bf16(y.x, y.y); w.y = cvt_pk_bf16(y.z, y.w); ((u32x2*)orow)[lane + 64 * j] = w; }
        else ((f32x4*)orow)[lane + 64 * j] = y; }
}

struct Args { const float* in[11]; float* out; unsigned char* ws; int ph_lo, ph_hi; };

__device__ __forceinline__ void gla_pair_info(int p, int& tok0, int& L, int& h) { h = p & 31; if (p < 64) { tok0 = (p >> 5) * LP; L = LP; } else { tok0 = NPT + ((p - 64) >> 5) * LSQ; L = LSQ; } }

#if GLA_NAIVE
__device__ __forceinline__ void gla_pair_naive(LAS unsigned char* lds, unsigned char* ws, const float* ghead, int p) {
    const int tid = threadIdx.x, lane = tid & 63, wave = tid >> 6;
    int tok0, L, h; gla_pair_info(p, tok0, L, h);
    const bf16_t* Q = (const bf16_t*)(ws + WS_Q); bf16_t* KF = (bf16_t*)(ws + WS_KF); const bf16_t* KB = (const bf16_t*)(ws + WS_KB);
    const bf16_t* V = (const bf16_t*)(ws + WS_V); bf16_t* GA = (bf16_t*)(ws + WS_GA);
    LAS float* Lq = (LAS float*)lds; LAS float* Lf = Lq + 16 * 128; LAS float* Lk = Lf + 16 * 128; LAS float* Lv = Lk + 16 * 128; LAS float* Lo = Lv + 16 * 128;
    const int v = tid & 127, kq = tid >> 7;
    for (int pass = 0; pass < 2; ++pass) {
        float S[32];
#pragma unroll
        for (int i = 0; i < 32; ++i) S[i] = 0.f;
        const bf16_t* F = pass ? KB : (const bf16_t*)KF;
        for (int blk = 0; blk < L / 16; ++blk) {
            { const int i = tid >> 5, c4 = (tid & 31) * 4; const int tau = blk * 16 + i; const int t = tok0 + (pass ? (L - 1 - tau) : tau);
              const size_t off = (size_t)t * D + h * DH + c4;
              const u32x2 wq = *(const u32x2*)(Q + off), wf = *(const u32x2*)(F + off), wv = *(const u32x2*)(V + off);
              const float lf0 = bf_lo(wf.x), lf1 = bf_hi(wf.x), lf2 = bf_lo(wf.y), lf3 = bf_hi(wf.y);
              const float f0 = fexp(lf0), f1 = fexp(lf1), f2 = fexp(lf2), f3 = fexp(lf3);
              *(LAS f32x4*)(Lq + i * 128 + c4) = (f32x4){bf_lo(wq.x), bf_hi(wq.x), bf_lo(wq.y), bf_hi(wq.y)};
              *(LAS f32x4*)(Lf + i * 128 + c4) = (f32x4){f0, f1, f2, f3};
              *(LAS f32x4*)(Lk + i * 128 + c4) = (f32x4){1.f - f0, 1.f - f1, 1.f - f2, 1.f - f3};
              *(LAS f32x4*)(Lv + i * 128 + c4) = (f32x4){bf_lo(wv.x), bf_hi(wv.x), bf_lo(wv.y), bf_hi(wv.y)}; }
            __syncthreads();
            for (int i = 0; i < 16; ++i) {
                const float vv = Lv[i * 128 + v]; float op = 0.f;
#pragma unroll
                for (int k4 = 0; k4 < 8; ++k4) {
                    const f32x4 f = *(const LAS f32x4*)(Lf + i * 128 + kq * 32 + k4 * 4), kx = *(const LAS f32x4*)(Lk + i * 128 + kq * 32 + k4 * 4), qx = *(const LAS f32x4*)(Lq + i * 128 + kq * 32 + k4 * 4);
#pragma unroll
                    for (int e = 0; e < 4; ++e) { S[k4 * 4 + e] = f[e] * S[k4 * 4 + e] + kx[e] * vv; op += S[k4 * 4 + e] * qx[e]; }
                }
                Lo[(i * 4 + kq) * 128 + v] = op;
            }
            __syncthreads();
#pragma unroll
            for (int j = 0; j < 2; ++j) { const int i = 2 * wave + j; const int tau = blk * 16 + i; const int t = tok0 + (pass ? (L - 1 - tau) : tau);
                const size_t off = (size_t)t * D + h * DH + 2 * lane;
                float o0 = 0.f, o1 = 0.f;
#pragma unroll
                for (int q = 0; q < 4; ++q) { const f32x2 x = *(const LAS f32x2*)(Lo + (i * 4 + q) * 128 + 2 * lane); o0 += x.x; o1 += x.y; }
                if (pass == 0) { *(unsigned*)(KF + off) = cvt_pk_bf16(o0, o1); }
                else { const unsigned wf = *(const unsigned*)(KF + off), wg = *(const unsigned*)(GA + off);
                    o0 += bf_lo(wf); o1 += bf_hi(wf);
                    const float ss = wave_sum(o0 * o0 + o1 * o1); const float rstd = 1.0f / sqrtf(ss * (1.f / DH) + EPS);
                    const f32x2 gh = *(const f32x2*)(ghead + h * DH + 2 * lane);
                    *(unsigned*)(GA + off) = cvt_pk_bf16(o0 * rstd * gh.x * bf_lo(wg), o1 * rstd * gh.y * bf_hi(wg)); }
            }
            __syncthreads();
        }
        VM_WAIT(); __syncthreads(); __builtin_amdgcn_fence(__ATOMIC_ACQUIRE, "agent"); VM_WAIT(); __syncthreads();
    }
}
#endif

constexpr int GL_QH = 0, GL_KT = 17408, GL_KTT = 34816, GL_VT = 53248, GL_ST = 71680, GL_SEG = 106496, GL_DV = 110592;
#define LBAR() do { asm volatile("s_waitcnt lgkmcnt(0)" ::: "memory"); __builtin_amdgcn_s_barrier(); asm volatile("" ::: "memory"); } while (0)
#define MFMA32(a, b, c) __builtin_amdgcn_mfma_f32_32x32x16_bf16((a), (b), (c), 0, 0, 0)
__device__ __forceinline__ void gla_pair_mfma(LAS unsigned char* lds, unsigned char* ws, const float* ghead, int p) {
    const int tid = threadIdx.x, lane = tid & 63, wave = __builtin_amdgcn_readfirstlane(tid >> 6);
    int tok0, L, h; gla_pair_info(p, tok0, L, h);
    const int nchunk = L >> 6, tq = wave >> 2, vt = wave & 3, l31 = lane & 31, hh = lane >> 5;
    const size_t colo = (size_t)h * DH + 2 * lane;
    const bf16_t* Q = (const bf16_t*)(ws + WS_Q) + colo; bf16_t* KF = (bf16_t*)(ws + WS_KF) + colo; const bf16_t* KB = (const bf16_t*)(ws + WS_KB) + colo;
    const bf16_t* V = (const bf16_t*)(ws + WS_V) + colo; bf16_t* GA = (bf16_t*)(ws + WS_GA) + colo;
    const f32x2 gh = *(const f32x2*)(ghead + h * DH + 2 * lane);
    for (int pass = 0; pass < 2; ++pass) {
        const bf16_t* F = pass ? KB : (const bf16_t*)KF;
        f32x16 s0, s1;
#pragma unroll
        for (int i = 0; i < 16; ++i) { s0[i] = 0.f; s1[i] = 0.f; }
        for (int i = tid; i < 34816 / 16; i += 512) ((LAS u32x4*)(lds + GL_ST))[i] = (u32x4){0u, 0u, 0u, 0u};
        unsigned cq[8], cf[8], cv[8];
        { const int tau0 = 8 * wave; const long t0 = tok0 + (pass ? (L - 1 - tau0) : tau0); const long stp = pass ? -1 : 1;
#pragma unroll
          for (int i = 0; i < 8; ++i) { const size_t ro = (size_t)(t0 + stp * i) * D; cq[i] = *(const unsigned*)(Q + ro); cf[i] = *(const unsigned*)(F + ro); cv[i] = *(const unsigned*)(V + ro); } }
        for (int c = 0; c < nchunk; ++c) {
            const int tau0 = 64 * c + 8 * wave; const long t0 = tok0 + (pass ? (L - 1 - tau0) : tau0); const long stp = pass ? -1 : 1;
            unsigned nq[8], nf[8], nv[8], cof[8], cga[8];
            if (c + 1 < nchunk) {
#pragma unroll
                for (int i = 0; i < 8; ++i) { const size_t ro = (size_t)(t0 + stp * (64 + i)) * D; nq[i] = *(const unsigned*)(Q + ro); nf[i] = *(const unsigned*)(F + ro); nv[i] = *(const unsigned*)(V + ro); }
            } else {
#pragma unroll
                for (int i = 0; i < 8; ++i) { nq[i] = 0u; nf[i] = 0u; nv[i] = 0u; }
            }
            if (pass) {
#pragma unroll
                for (int i = 0; i < 8; ++i) { const size_t ro = (size_t)(t0 + stp * i) * D; cof[i] = *(const unsigned*)(KF + ro); cga[i] = *(const unsigned*)(GA + ro); }
            } else {
#pragma unroll
                for (int i = 0; i < 8; ++i) { cof[i] = 0u; cga[i] = 0u; }
            }
            float b0[8], b1[8]; { float c0 = 0.f, c1 = 0.f;
#pragma unroll
                for (int i = 0; i < 8; ++i) { c0 += bf_lo(cf[i]); c1 += bf_hi(cf[i]); b0[i] = c0; b1[i] = c1; }
                *(LAS f32x2*)(lds + GL_SEG + (wave * 128 + 2 * lane) * 4) = (f32x2){c0, c1}; }
            LBAR();
            { float p0 = 0.f, p1 = 0.f;
#pragma unroll
              for (int w = 0; w < 7; ++w) if (w < wave) { const f32x2 x = *(const LAS f32x2*)(lds + GL_SEG + (w * 128 + 2 * lane) * 4); p0 += x.x; p1 += x.y; }
              unsigned kc0[4], kc1[4], vc0[4], vc1[4]; float kp0 = 0.f, kp1 = 0.f;
#pragma unroll
              for (int i = 0; i < 8; ++i) { const float bb0 = b0[i] + p0, bb1 = b1[i] + p1;
                  const float q0 = bf_lo(cq[i]) * fexp(bb0), q1 = bf_hi(cq[i]) * fexp(bb1);
                  const float k0 = (1.f - fexp(bf_lo(cf[i]))) * fexp(-bb0), k1 = (1.f - fexp(bf_hi(cf[i]))) * fexp(-bb1);
                  *(LAS unsigned*)(lds + GL_QH + (8 * wave + i) * 272 + 4 * lane) = cvt_pk_bf16(q0, q1);
                  *(LAS unsigned*)(lds + GL_KT + (8 * wave + i) * 272 + 4 * lane) = cvt_pk_bf16(k0, k1);
                  if (i & 1) { kc0[i >> 1] = cvt_pk_bf16(kp0, k0); kc1[i >> 1] = cvt_pk_bf16(kp1, k1); vc0[i >> 1] = (cv[i - 1] & 0xffffu) | (cv[i] << 16); vc1[i >> 1] = (cv[i - 1] >> 16) | (cv[i] & 0xffff0000u); }
                  else { kp0 = k0; kp1 = k1; } }
              if (wave == 7) *(LAS f32x2*)(lds + GL_DV + 2 * lane * 4) = (f32x2){fexp(b0[7] + p0), fexp(b1[7] + p1)};
              *(LAS u32x4*)(lds + GL_KTT + (2 * lane) * 144 + 16 * wave) = (u32x4){kc0[0], kc0[1], kc0[2], kc0[3]};
              *(LAS u32x4*)(lds + GL_KTT + (2 * lane + 1) * 144 + 16 * wave) = (u32x4){kc1[0], kc1[1], kc1[2], kc1[3]};
              *(LAS u32x4*)(lds + GL_VT + (2 * lane) * 144 + 16 * wave) = (u32x4){vc0[0], vc0[1], vc0[2], vc0[3]};
              *(LAS u32x4*)(lds + GL_VT + (2 * lane + 1) * 144 + 16 * wave) = (u32x4){vc1[0], vc1[1], vc1[2], vc1[3]}; }
            LBAR();
            f32x16 oacc;
#pragma unroll
            for (int i = 0; i < 16; ++i) oacc[i] = 0.f;
            bf16x8 qf[8];
#pragma unroll
            for (int ks = 0; ks < 8; ++ks) qf[ks] = *(const LAS bf16x8*)(lds + GL_QH + (32 * tq + l31) * 272 + hh * 16 + ks * 32);
#pragma unroll
            for (int ks = 0; ks < 8; ++ks) { const bf16x8 sb = *(const LAS bf16x8*)(lds + GL_ST + (32 * vt + l31) * 272 + hh * 16 + ks * 32); oacc = MFMA32(qf[ks], sb, oacc); }
            for (int st = 0; st <= tq; ++st) {
                f32x16 x;
#pragma unroll
                for (int i = 0; i < 16; ++i) x[i] = 0.f;
#pragma unroll
                for (int ks = 0; ks < 8; ++ks) { const bf16x8 ka = *(const LAS bf16x8*)(lds + GL_KT + (32 * st + l31) * 272 + hh * 16 + ks * 32); x = MFMA32(ka, qf[ks], x); }
                if (st == tq) {
#pragma unroll
                    for (int r = 0; r < 16; ++r) { const int sl = (r & 3) + 8 * (r >> 2) + 4 * hh; x[r] = (sl <= l31) ? x[r] : 0.f; }
                }
#pragma unroll
                for (int sp = 0; sp < 2; ++sp) {
                    u32x4 aw; aw.x = cvt_pk_bf16(x[8 * sp + 0], x[8 * sp + 1]); aw.y = cvt_pk_bf16(x[8 * sp + 2], x[8 * sp + 3]); aw.z = cvt_pk_bf16(x[8 * sp + 4], x[8 * sp + 5]); aw.w = cvt_pk_bf16(x[8 * sp + 6], x[8 * sp + 7]);
                    const LAS unsigned char* vp = lds + GL_VT + (32 * vt + l31) * 144 + 64 * st + 32 * sp + 8 * hh;
                    const u32x2 blo = *(const LAS u32x2*)vp, bhi = *(const LAS u32x2*)(vp + 16);
                    const u32x4 bw = (u32x4){blo.x, blo.y, bhi.x, bhi.y};
                    oacc = MFMA32(__builtin_bit_cast(bf16x8, aw), __builtin_bit_cast(bf16x8, bw), oacc);
                }
            }
#pragma unroll
            for (int ks = 0; ks < 4; ++ks) { const bf16x8 vb = *(const LAS bf16x8*)(lds + GL_VT + (32 * vt + l31) * 144 + hh * 16 + ks * 32);
                const bf16x8 ka0 = *(const LAS bf16x8*)(lds + GL_KTT + (64 * tq + l31) * 144 + hh * 16 + ks * 32), ka1 = *(const LAS bf16x8*)(lds + GL_KTT + (64 * tq + 32 + l31) * 144 + hh * 16 + ks * 32);
                s0 = MFMA32(ka0, vb, s0); s1 = MFMA32(ka1, vb, s1); }
#pragma unroll
            for (int g = 0; g < 4; ++g) { const f32x4 d0 = *(const LAS f32x4*)(lds + GL_DV + (64 * tq + 8 * g + 4 * hh) * 4), d1 = *(const LAS f32x4*)(lds + GL_DV + (64 * tq + 32 + 8 * g + 4 * hh) * 4);
#pragma unroll
                for (int e = 0; e < 4; ++e) { s0[4 * g + e] *= d0[e]; s1[4 * g + e] *= d1[e]; } }
            LBAR();
#pragma unroll
            for (int r = 0; r < 16; ++r) { const int tl = (r & 3) + 8 * (r >> 2) + 4 * hh; *(LAS float*)(lds + ((32 * tq + tl) * 132 + 32 * vt + l31) * 4) = oacc[r]; }
#pragma unroll
            for (int g = 0; g < 4; ++g) {
                *(LAS u32x2*)(lds + GL_ST + (32 * vt + l31) * 272 + (64 * tq + 8 * g + 4 * hh) * 2) = (u32x2){cvt_pk_bf16(s0[4 * g], s0[4 * g + 1]), cvt_pk_bf16(s0[4 * g + 2], s0[4 * g + 3])};
                *(LAS u32x2*)(lds + GL_ST + (32 * vt + l31) * 272 + (64 * tq + 32 + 8 * g + 4 * hh) * 2) = (u32x2){cvt_pk_bf16(s1[4 * g], s1[4 * g + 1]), cvt_pk_bf16(s1[4 * g + 2], s1[4 * g + 3])}; }
            LBAR();
#pragma unroll
            for (int i = 0; i < 8; ++i) { const size_t ro = (size_t)(t0 + stp * i) * D; f32x2 o = *(const LAS f32x2*)(lds + ((8 * wave + i) * 132 + 2 * lane) * 4);
                if (pass == 0) { *(unsigned*)(KF + ro) = cvt_pk_bf16(o.x, o.y); }
                else { o.x += bf_lo(cof[i]); o.y += bf_hi(cof[i]);
                    const float ss = wave_sum(o.x * o.x + o.y * o.y); const float rstd = 1.0f / sqrtf(ss * (1.f / DH) + EPS);
                    *(unsigned*)(GA + ro) = cvt_pk_bf16(o.x * rstd * gh.x * bf_lo(cga[i]), o.y * rstd * gh.y * bf_hi(cga[i])); } }
#pragma unroll
            for (int i = 0; i < 8; ++i) { cq[i] = nq[i]; cf[i] = nf[i]; cv[i] = nv[i]; }
        }
        VM_WAIT(); __syncthreads(); __builtin_amdgcn_fence(__ATOMIC_ACQUIRE, "agent"); VM_WAIT(); __syncthreads();
    }
}

__device__ __forceinline__ void gla_phase(LAS unsigned char* lds, unsigned char* ws, const float* ghead, int vcu, int G) {
#if GLA_NAIVE
#define GLA_PAIR gla_pair_naive
#else
#define GLA_PAIR gla_pair_mfma
#endif
    if (G == 256) { GLA_PAIR(lds, ws, ghead, vcu); if (vcu >= 64 && vcu < 128) GLA_PAIR(lds, ws, ghead, vcu + 192); }
    else { for (int p = vcu; p < 320; p += G) GLA_PAIR(lds, ws, ghead, p); }
}

__global__ void __launch_bounds__(NWAVES * 64, 2) fwd_kernel(Args args) {
    extern __shared__ __attribute__((aligned(16))) unsigned char lds_raw[];
    LAS unsigned char* lds = (LAS unsigned char*)lds_raw;
    volatile LAS unsigned* MISC = (volatile LAS unsigned*)(lds + MISC_OFF);
    const int tid = threadIdx.x, lane = tid & 63, wave = __builtin_amdgcn_readfirstlane(tid >> 6);
    const int G = gridDim.x; const int bx = blockIdx.x; const int vcu = (G % 8 == 0) ? (bx % 8) * (G / 8) + bx / 8 : bx;
    unsigned char* ws = args.ws;
    unsigned* ctl = (unsigned*)(ws + WS_CTL);
    for (int u = tid; u < (LDS_BYTES - LDSCTL_OFF) / 4; u += NWAVES * 64) ((LAS unsigned*)(lds + LDSCTL_OFF))[u] = 0u;
    __syncthreads();
    XcdBarrier bar; bar.bar = ctl + CW_BAR; bar.x = 0; bar.st = nullptr;
    if (MK_N_LAUNCHES == 1) bar = xcd_barrier_post(ctl + CW_BAR, MISC + 8);
    const int lo = args.ph_lo, hi = args.ph_hi;
#define IN(k) (lo <= (k) && (k) < hi)
#define BOTH(k) (IN(k) && IN((k) + 1))
#define GRID_BAR() do { if (MK_N_LAUNCHES == 1) xcd_barrier(bar); } while (0)
    Ctx cx; cx.ws = ws; cx.xp = args.in[0]; cx.xs = args.in[1]; cx.out = args.out; cx.G = G; cx.c = bx;
    const int gw = vcu * NWAVES + wave, NGW = G * NWAVES;

    if (IN(0)) {
        LAS float* scr = (LAS float*)(lds + wave * 16384);
        const float* w_in = args.in[3]; const float* w_a = args.in[7]; const float* w_b = args.in[8]; const float* w_o = args.in[9];
        constexpr int I_IN = (D / 64) * (32768 / 32), I_A = (D / 64) * (D / 32), I_B = (DB / 64) * (D / 32), I_O = I_A;
        for (int it = gw; it < I_IN + I_A + I_B + I_O; it += NGW) {
            int r = it;
            if (r < I_IN) { p0_transpose_item(w_in, D, 32768, (bf16_t*)(ws + WS_WIN), scr, r, lane); continue; } r -= I_IN;
            if (r < I_A) { p0_transpose_item(w_a, D, D, (bf16_t*)(ws + WS_WA), scr, r, lane); continue; } r -= I_A;
            if (r < I_B) { p0_transpose_item(w_b, DB, D, (bf16_t*)(ws + WS_WB), scr, r, lane); continue; } r -= I_B;
            p0_transpose_item(w_o, D, D, (bf16_t*)(ws + WS_WO), scr, r, lane);
        }
        for (int m = gw; m < TOK; m += NGW) { const float* xr = (m < NPT) ? args.in[0] + (size_t)m * D : args.in[1] + (size_t)(m - NPT) * D;
            rms_row<true>(xr, args.in[2], (bf16_t*)(ws + WS_H) + (size_t)m * D, lane); }
        for (int i = bx * 512 + tid; i < 2 * D; i += G * 512) { const float* lbp = (i < D) ? args.in[4] : args.in[5]; const int c = i & (D - 1);
            const float a0 = lbp[c], a1 = lbp[D + c]; ((float*)(ws + (i < D ? WS_LBF : WS_LBB)))[c] = 1.0f / (1.0f + expf(a1 - a0)); }
        for (int i = bx * 512 + tid; i < 1024 * 512; i += G * 512) { const int r = i >> 9, c = i & 511, j = r & 511, part = r >> 9; const float ph = (float)((j * c) & 511) * (1.f / 512.f);
            const float vv = (part ? __builtin_amdgcn_sinf(ph) : __builtin_amdgcn_cosf(ph)) * 0.04419417382415922f; ((bf16_t*)(ws + WS_DFTC))[i] = (bf16_t)f2bf(vv); }
        if (BOTH(0)) GRID_BAR();
    }
    if (IN(1)) { ProbG1a P; P.init(cx); pg8::gemm_phase(lds, P); if (BOTH(1)) GRID_BAR(); }
    if (IN(2)) { gla_phase(lds, ws, args.in[6], vcu, G); if (BOTH(2)) GRID_BAR(); }
    if (IN(3)) {
        { ProbPlain P; P.init(cx, ws + WS_GA, ws + WS_WA, ws + WS_PA, D, D); pg8::gemm_phase(lds, P); }
        { ProbG1b P; P.init(cx); pg8::gemm_phase(lds, P); }
        for (size_t i = ((size_t)bx * 512 + tid) * 2; i < (size_t)LP * 2 * LP; i += (size_t)G * 1024) { const int lp = (int)(i >> 14), kk = (int)(i & 16383), part = kk >> 13, l = kk & 8191;
            const float p0 = (float)((lp * l) & 8191) * (1.f / 8192.f), p1 = (float)((lp * (l + 1)) & 8191) * (1.f / 8192.f); const float sc = 0.011048543456039806f;
            const float v0 = part ? -__builtin_amdgcn_sinf(p0) : __builtin_amdgcn_cosf(p0), v1 = part ? -__builtin_amdgcn_sinf(p1) : __builtin_amdgcn_cosf(p1);
            *(unsigned*)((bf16_t*)(ws + WS_DFTS8) + i) = cvt_pk_bf16(v0 * sc, v1 * sc); }
        for (size_t i = ((size_t)bx * 512 + tid) * 2; i < (size_t)LSQ * 2 * LSQ; i += (size_t)G * 1024) { const int lp = (int)(i >> 12), kk = (int)(i & 4095), part = kk >> 11, l = kk & 2047;
            const float p0 = (float)((lp * l) & 2047) * (1.f / 2048.f), p1 = (float)((lp * (l + 1)) & 2047) * (1.f / 2048.f); const float sc = 0.022097086912079608f;
            const float v0 = part ? -__builtin_amdgcn_sinf(p0) : __builtin_amdgcn_cosf(p0), v1 = part ? -__builtin_amdgcn_sinf(p1) : __builtin_amdgcn_cosf(p1);
            *(unsigned*)((bf16_t*)(ws + WS_DFTS2) + i) = cvt_pk_bf16(v0 * sc, v1 * sc); }
        if (BOTH(3)) GRID_BAR();
    }
    if (IN(4)) { ProbDft1 P; P.init(cx); pg8::gemm_phase(lds, P); if (BOTH(4)) GRID_BAR(); }
    if (IN(5)) { { ProbDft2 P; P.init(cx, 0); pg8::gemm_phase(lds, P); } { ProbDft2 P; P.init(cx, 1); pg8::gemm_phase(lds, P); } if (BOTH(5)) GRID_BAR(); }
    if (IN(6)) { ProbPlain P; P.init(cx, ws + WS_BOUT, ws + WS_WB, ws + WS_PB, D, DB); pg8::gemm_phase(lds, P); if (BOTH(6)) GRID_BAR(); }
    if (IN(7)) { ProbMerge P; P.init(cx); pg8::gemm_phase(lds, P); if (BOTH(7)) GRID_BAR(); }
    if (IN(8)) { ProbOut P; P.init(cx); pg8::gemm_phase(lds, P); if (BOTH(8)) GRID_BAR(); }
    if (IN(9)) { for (int m = gw; m < TOK; m += NGW) rms_row<false>(args.out + (size_t)m * D, args.in[10], args.out + (size_t)m * D, lane); }
#undef IN
#undef BOTH
#undef GRID_BAR
}

extern "C" void kernel_launch(void* const* d_in, const int* in_sizes, int n_in, void* d_out, int out_size, void* d_ws, size_t ws_size, hipStream_t stream) {
    static int grid = 0;
    if (grid == 0) {
        if (n_in != 11 || ws_size < WS_END) { fprintf(stderr, "kernel_launch: need 11 inputs and >= %zu bytes of workspace (got %d, %zu)\n", (size_t)WS_END, n_in, ws_size); grid = -1; return; }
        int dev = 0, cus = 0;
        if (hipGetDevice(&dev) != hipSuccess || hipDeviceGetAttribute(&cus, hipDeviceAttributeMultiprocessorCount, dev) != hipSuccess) { grid = -1; return; }
        if (hipFuncSetAttribute((const void*)fwd_kernel, hipFuncAttributeMaxDynamicSharedMemorySize, LDS_BYTES) != hipSuccess) { fprintf(stderr, "kernel_launch: hipFuncSetAttribute failed\n"); grid = -1; return; }
        int per_cu = 0;
        if (hipOccupancyMaxActiveBlocksPerMultiprocessor(&per_cu, (const void*)fwd_kernel, NWAVES * 64, LDS_BYTES) != hipSuccess || per_cu < 1) fprintf(stderr, "kernel_launch: occupancy query reports %d\n", per_cu);
        (void)hipGetLastError();
        grid = cus;
    }
    if (grid < 0) return;
    (void)hipMemsetAsync((char*)d_ws + WS_CTL, 0, CTL_ZERO_BYTES, stream);
    Args a{};
    for (int i = 0; i < 11; ++i) a.in[i] = (const float*)d_in[i];
    a.out = (float*)d_out; a.ws = (unsigned char*)d_ws;
    if (MK_N_LAUNCHES == 1) { a.ph_lo = 0; a.ph_hi = N_PHASES; hipLaunchKernelGGL(fwd_kernel, dim3(grid), dim3(NWAVES * 64), LDS_BYTES, stream, a); }
    else for (int li = 0; li < N_PHASES; ++li) { a.ph_lo = li; a.ph_hi = li + 1; hipLaunchKernelGGL(fwd_kernel, dim3(grid), dim3(NWAVES * 64), LDS_BYTES, stream, a); }
}
```

```cpp
#include <hip/hip_runtime.h>
#include <cstdio>
#include <cstdint>

#define LAS __attribute__((address_space(3)))
#define GAS __attribute__((address_space(1)))
typedef unsigned short bf16_t;
typedef short bf16x8 __attribute__((ext_vector_type(8)));
typedef short bf16x4 __attribute__((ext_vector_type(4)));
typedef float f32x2 __attribute__((ext_vector_type(2)));
typedef float f32x4 __attribute__((ext_vector_type(4)));
typedef float f32x16 __attribute__((ext_vector_type(16)));
typedef unsigned u32x2 __attribute__((ext_vector_type(2)));
typedef unsigned u32x4 __attribute__((ext_vector_type(4)));

#ifndef MK_N_LAUNCHES
#define MK_N_LAUNCHES 1
#endif
#ifndef GLA_NAIVE
#define GLA_NAIVE 0
#endif

constexpr int D = 4096, TOK = 32768, NPT = 16384, LP = 8192, LSQ = 2048, NH = 32, DH = 128, DB = 2048, CG = 512;
constexpr int C_U = 20480, C_MA = 24576, C_MB = 28672;
constexpr float EPS = 1e-6f;
constexpr int N_PHASES = 10;
constexpr int REP[10] = {1, 1, 1, 1, 1, 1, 1, 1, 1, 1};

constexpr size_t MiB = 1u << 20;
constexpr size_t WS_CTL = 0, CTL_ZERO_BYTES = 1 * MiB;
constexpr size_t WS_LBF = 1 * MiB, WS_LBB = 1 * MiB + 16384;
constexpr size_t WS_WIN = 2 * MiB, WS_WA = 258 * MiB, WS_WB = 290 * MiB, WS_WO = 306 * MiB, WS_H = 338 * MiB;
constexpr size_t WS_Q = 594 * MiB, WS_KF = 850 * MiB, WS_KB = 1106 * MiB, WS_V = 1362 * MiB, WS_GA = 1618 * MiB;
constexpr size_t WS_DFTC = 1874 * MiB, WS_DFTS2 = 1876 * MiB, WS_BOUT = 1892 * MiB, WS_END = 2020 * MiB;
constexpr size_t WS_PA = WS_Q, WS_U = WS_KF, WS_SGB = WS_KF + 128 * MiB, WS_M = WS_KF, WS_ABT = WS_KB, WS_DFTS8 = WS_V, WS_PB = WS_GA;
constexpr size_t ABT_SAMPLE_OFF = (size_t)2 * 2048 * 16384;
constexpr int CW_TMO = 0, CW_BAR = 4096;

constexpr int RING_BYTES = 131072;
constexpr int LDSCTL_OFF = RING_BYTES, MISC_OFF = LDSCTL_OFF + 320;
constexpr int LDS_BYTES = 147456;
constexpr int NWAVES = 8;

typedef __bf16 bf16x2_t __attribute__((ext_vector_type(2)));
__device__ __forceinline__ unsigned cvt_pk_bf16(float lo, float hi) { f32x2 v = {lo, hi}; bf16x2_t b = __builtin_convertvector(v, bf16x2_t); return __builtin_bit_cast(unsigned, b); }
typedef _Float16 half2_t __attribute__((ext_vector_type(2)));
__device__ __forceinline__ unsigned cvt_pk_f16(float lo, float hi) { f32x2 v = {lo, hi}; half2_t b = __builtin_convertvector(v, half2_t); return __builtin_bit_cast(unsigned, b); }
__device__ __forceinline__ f32x2 unpk_f16(unsigned w) { const half2_t b = __builtin_bit_cast(half2_t, w); return __builtin_convertvector(b, f32x2); }
__device__ __forceinline__ float bf_lo(unsigned w) { return __uint_as_float(w << 16); }
__device__ __forceinline__ float bf_hi(unsigned w) { return __uint_as_float(w & 0xffff0000u); }
__device__ __forceinline__ float fexp(float x) { return __builtin_amdgcn_exp2f(x * 1.44269504089f); }
__device__ __forceinline__ float frcp(float x) { return __builtin_amdgcn_rcpf(x); }
__device__ __forceinline__ float fsig(float x) { return frcp(1.f + fexp(-x)); }
__device__ __forceinline__ float fsilu(float x) { return x * fsig(x); }
__device__ __forceinline__ float flog(float x) { return __builtin_amdgcn_logf(x) * 0.69314718056f; }
__device__ __forceinline__ float wave_sum(float v) {
#pragma unroll
    for (int o = 1; o < 64; o <<= 1) v += __shfl_xor(v, o);
    return v;
}
#define LDS_WAIT() asm volatile("s_waitcnt lgkmcnt(0)" ::: "memory")
#define VM_WAIT() asm volatile("s_waitcnt vmcnt(0)" ::: "memory")

namespace pg8 {
constexpr int BM = 256, BK = 64, HALF = 128, HTB = HALF * BK * 2, STAGE_BYTES = 8 * HTB, NXCD = 8, WGM = 8;
__host__ __device__ __forceinline__ int lds_byte(int r, int c) { const int st = (r >> 4) * 2 + (c >> 5), rr = r & 15, cc = c & 31, ob = rr * 64 + cc * 2; return st * 1024 + (ob ^ (((ob >> 9) & 1) << 5)); }
__host__ __device__ __forceinline__ void stage_rc(int b, int& R, int& C) { const int st = b / 1024, sb = b % 1024, swz = sb ^ (((sb >> 9) & 1) << 5); R = (st >> 1) * 16 + swz / 64; C = (st & 1) * 32 + (swz % 64) / 2; }
__host__ __device__ __forceinline__ int perm32(int rho) { const int n = rho >> 4, i = rho & 15; return 8 * (i >> 2) + 4 * n + (i & 3); }

struct Unit { int pm, pn; };
struct Ptrs { const char* a0; const char* a1; const char* b0; const char* b1; };

struct StaticOrder {
    int nM, nN, nwg, G, c;
    __host__ __device__ void init(int M, int N, int G_, int c_) { nM = M / BM; nN = N / BM; nwg = nM * nN; G = G_; c = c_; }
    __host__ __device__ bool next(int i, Unit& u) const {
        const long L = (long)i * G + c; if (L >= nwg) return false;
        int wgid = (int)L; { const int q = nwg / NXCD, r = nwg % NXCD, xcd = wgid % NXCD, off = wgid / NXCD; wgid = (xcd < r ? xcd * (q + 1) : r * (q + 1) + (xcd - r) * q) + off; }
        const int nig = WGM * nN, gid = wgid / nig, fm = gid * WGM, gsz = (nM - fm) < WGM ? (nM - fm) : WGM;
        u.pm = fm + ((wgid % nig) % gsz); u.pn = (wgid % nig) / gsz; return true;
    }
};

template <class P>
__device__ __forceinline__ void gemm_phase(LAS unsigned char* lds, const P& p) {
    const int tid = threadIdx.x, wid = __builtin_amdgcn_readfirstlane(tid >> 6), lane = tid & 63, wr = wid >> 2, wc = wid & 3, fr = lane & 15, fq = lane >> 4;
    const int nt = p.nt;
    unsigned voffA[2], voffB[2];
#pragma unroll
    for (int i = 0; i < 2; ++i) { int R, C; stage_rc(tid * 16 + i * 8192, R, C); const int Rb = P::PERM ? ((R & ~31) + perm32(R & 31)) : R;
        voffA[i] = (unsigned)(R * p.lda + C) * 2u; voffB[i] = (unsigned)(Rb * p.ldb + C) * 2u; }
    const size_t kstep = (size_t)(BK * 2);
    const unsigned ldsw = (unsigned)wid * 1024u;
    const int aoff = lds_byte(wr * 64 + fr, fq * 8), boff = lds_byte(wc * 32 + fr, fq * 8);
#define PG8_SA(b, h) (((b) * 2 + (h)) * HTB)
#define PG8_SB(b, h) ((4 + (b) * 2 + (h)) * HTB)
#define PG8_STAGE(bufoff, gbase, voff) do { _Pragma("unroll") for (int _i = 0; _i < 2; ++_i) \
        __builtin_amdgcn_global_load_lds((const unsigned*)((const char*)(gbase) + (voff)[_i]), (LAS unsigned*)(lds + (bufoff) + ldsw + _i * 8192), 16, 0, 0); } while (0)
#define PG8_LDA(dst, b, h) do { _Pragma("unroll") for (int m = 0; m < 4; ++m) _Pragma("unroll") for (int k = 0; k < 2; ++k) dst[m][k] = *(const LAS bf16x8*)(lds + PG8_SA(b, h) + aoff + m * 2048 + k * 1024); } while (0)
#define PG8_LDB(dst, b, h) do { _Pragma("unroll") for (int n = 0; n < 2; ++n) _Pragma("unroll") for (int k = 0; k < 2; ++k) dst[n][k] = *(const LAS bf16x8*)(lds + PG8_SB(b, h) + boff + n * 2048 + k * 1024); } while (0)
#define PG8_MMA(ai, bj, At, Bt) do { __builtin_amdgcn_s_setprio(1); _Pragma("unroll") for (int m = 0; m < 4; ++m) _Pragma("unroll") for (int n = 0; n < 2; ++n) _Pragma("unroll") for (int k = 0; k < 2; ++k) \
        acc[ai][bj][m][n] = __builtin_amdgcn_mfma_f32_16x16x32_bf16(Bt[n][k], At[m][k], acc[ai][bj][m][n], 0, 0, 0); __builtin_amdgcn_s_setprio(0); } while (0)
#define PG8_WAIT_V(n) asm volatile("s_waitcnt vmcnt(" #n ")" ::: "memory")
#define PG8_WAIT_L(n) asm volatile("s_waitcnt lgkmcnt(" #n ")" ::: "memory")
#define PG8_BAR __builtin_amdgcn_s_barrier()
#define PG8_SCHED __builtin_amdgcn_sched_barrier(0)
    Unit cur, nxt; int ui = 0;
    if (!p.next(0, cur)) return;
    f32x4 acc[2][2][4][2];
#pragma unroll
    for (int a = 0; a < 2; ++a)
#pragma unroll
        for (int b = 0; b < 2; ++b)
#pragma unroll
            for (int m = 0; m < 4; ++m)
#pragma unroll
                for (int n = 0; n < 2; ++n) acc[a][b][m][n] = (f32x4){0.f, 0.f, 0.f, 0.f};
    bf16x8 At[4][2], B0[2][2], B1[2][2];
    Ptrs cq; p.ptrs(cur, cq);
    PG8_STAGE(PG8_SB(0, 0), cq.b0, voffB); PG8_STAGE(PG8_SB(0, 1), cq.b1, voffB); PG8_STAGE(PG8_SA(0, 0), cq.a0, voffA); PG8_STAGE(PG8_SA(0, 1), cq.a1, voffA);
    if (wr == 1) PG8_BAR;
    PG8_WAIT_V(2); PG8_BAR;
    PG8_STAGE(PG8_SB(1, 0), cq.b0 + kstep, voffB); PG8_STAGE(PG8_SA(1, 0), cq.a0 + kstep, voffA); PG8_STAGE(PG8_SB(1, 1), cq.b1 + kstep, voffB);
    PG8_WAIT_V(6); PG8_BAR;
    for (;;) {
        const bool has_next = p.next(ui + 1, nxt);
        Ptrs nq = cq; if (has_next) p.ptrs(nxt, nq);
        for (int t = 0; t < nt; t += 2) {
            const bool last = (t == nt - 2);
            const size_t o1 = (size_t)(t + 1) * kstep, o2 = (size_t)(t + 2) * kstep;
            const char* a1_1 = cq.a1 + o1;
            const char* a2_0 = last ? nq.a0 : cq.a0 + o2; const char* a2_1 = last ? nq.a1 : cq.a1 + o2;
            const char* b2_0 = last ? nq.b0 : cq.b0 + o2; const char* b2_1 = last ? nq.b1 : cq.b1 + o2;
            PG8_LDB(B0, 0, 0); PG8_LDB(B1, 0, 1); PG8_SCHED; PG8_LDA(At, 0, 0); PG8_STAGE(PG8_SA(1, 1), a1_1, voffA);
            PG8_WAIT_V(8); PG8_WAIT_L(0); PG8_BAR; PG8_MMA(0, 0, At, B0); PG8_MMA(0, 1, At, B1); PG8_BAR; PG8_SCHED;
            PG8_LDA(At, 0, 1); PG8_STAGE(PG8_SB(0, 0), b2_0, voffB); PG8_STAGE(PG8_SB(0, 1), b2_1, voffB); PG8_STAGE(PG8_SA(0, 0), a2_0, voffA);
            PG8_WAIT_V(8); PG8_WAIT_L(0); PG8_BAR; PG8_MMA(1, 0, At, B0); PG8_MMA(1, 1, At, B1); PG8_BAR; PG8_SCHED;
            PG8_LDB(B0, 1, 0); PG8_LDB(B1, 1, 1); PG8_SCHED; PG8_LDA(At, 1, 0); PG8_STAGE(PG8_SA(0, 1), a2_1, voffA);
            PG8_WAIT_V(8); PG8_WAIT_L(0); PG8_BAR; PG8_MMA(0, 0, At, B0); PG8_MMA(0, 1, At, B1); PG8_BAR; PG8_SCHED;
            PG8_LDA(At, 1, 1); PG8_STAGE(PG8_SB(1, 0), b2_0 + kstep, voffB); PG8_STAGE(PG8_SB(1, 1), b2_1 + kstep, voffB); PG8_STAGE(PG8_SA(1, 0), a2_0 + kstep, voffA);
            PG8_WAIT_V(8); PG8_WAIT_L(0); PG8_BAR; PG8_MMA(1, 0, At, B0); PG8_MMA(1, 1, At, B1); PG8_BAR; PG8_SCHED;
        }
        if (wr == 0) PG8_BAR;
        p.epi(acc, cur, wr, wc, fr, fq);
        if (!has_next) break;
#pragma unroll
        for (int a = 0; a < 2; ++a)
#pragma unroll
            for (int b = 0; b < 2; ++b)
#pragma unroll
                for (int m = 0; m < 4; ++m)
#pragma unroll
                    for (int n = 0; n < 2; ++n) acc[a][b][m][n] = (f32x4){0.f, 0.f, 0.f, 0.f};
        cur = nxt; cq = nq; ++ui;
        if (wr == 1) PG8_BAR;
    }
    PG8_WAIT_V(0);
    PG8_BAR;
#undef PG8_SA
#undef PG8_SB
#undef PG8_STAGE
#undef PG8_LDA
#undef PG8_LDB
#undef PG8_MMA
#undef PG8_WAIT_V
#undef PG8_WAIT_L
#undef PG8_BAR
#undef PG8_SCHED
}
}

#define XB_TMO      128
#define XB_XCNT(j)  (256  + 64 * (j))
#define XB_XSUB(j)  (1280 + 64 * (j))
#define XB_XGEN(j)  (2304 + 64 * (j))
#define XB_TOP      3328
#define XB_TOPGEN   3392
#define XCD_BAR_WORDS 3456
#define XB_SPIN_CAP (1u << 18)
__device__ __forceinline__ unsigned xb_ld(unsigned* p)              { return __hip_atomic_load(p, __ATOMIC_RELAXED, __HIP_MEMORY_SCOPE_AGENT); }
__device__ __forceinline__ unsigned xb_add(unsigned* p, unsigned v) { return __hip_atomic_fetch_add(p, v, __ATOMIC_RELAXED, __HIP_MEMORY_SCOPE_AGENT); }
__device__ __forceinline__ unsigned xb_xcc_id() { return (unsigned)__builtin_amdgcn_s_getreg((3 << 11) | 20) & 0xFu; }
#define XB_SPIN(cond, bar) do { unsigned _sp = 0; while (cond) { __builtin_amdgcn_s_sleep(1); \
    if ((++_sp & 255u) == 0u) { if (xb_ld(&(bar)[XB_TMO])) break; if (_sp > XB_SPIN_CAP) { atomicAdd(&(bar)[XB_TMO], 1u); break; } } } } while (0)
struct XcdBarrier { unsigned* bar; unsigned x; volatile LAS unsigned* st; };
__device__ __forceinline__ XcdBarrier xcd_barrier_post(unsigned* bar, volatile LAS unsigned* st) {
    XcdBarrier b; b.bar = bar; b.x = xb_xcc_id(); b.st = st;
    if (threadIdx.x == 0) (void)xb_add(&bar[XB_XCNT(b.x)], 1u);
    return b;
}
__device__ __forceinline__ void xcd_barrier_complete(unsigned* bar, unsigned x, unsigned& nloc, unsigned& nx) {
    const unsigned G = gridDim.x * gridDim.y * gridDim.z;
    unsigned sum, cnt, mine, sp = 0u;
    for (;;) {
        sum = 0u; cnt = 0u; mine = 0u;
#pragma unroll
        for (unsigned j = 0; j < 16; ++j) { const unsigned c = xb_ld(&bar[XB_XCNT(j)]); sum += c; cnt += (c > 0u) ? 1u : 0u; mine = (j == x) ? c : mine; }
        if (sum == G) break;
        __builtin_amdgcn_s_sleep(1);
        if ((++sp & 255u) == 0u) { if (xb_ld(&bar[XB_TMO])) break; if (sp > XB_SPIN_CAP) { atomicAdd(&bar[XB_TMO], 1u); break; } }
    }
    nloc = mine > 0u ? mine : 1u; nx = cnt > 0u ? cnt : 1u;
}
__device__ __forceinline__ void xcd_barrier(const XcdBarrier& b) {
    asm volatile("s_waitcnt vmcnt(0)" ::: "memory");
    __syncthreads();
    if (threadIdx.x == 0) {
        unsigned* bar = b.bar;
        __builtin_amdgcn_s_waitcnt(0);
        unsigned nloc = b.st[0], nx = b.st[1];
        if (nloc == 0u) { xcd_barrier_complete(bar, b.x, nloc, nx); b.st[0] = nloc; b.st[1] = nx; }
        const unsigned old = xb_add(&bar[XB_XSUB(b.x)], 1u);
        const unsigned gen = old / nloc;
        if (old + 1u == (gen + 1u) * nloc) {
            __builtin_amdgcn_fence(__ATOMIC_RELEASE, "agent");
            asm volatile("s_waitcnt vmcnt(0)" ::: "memory");
            const unsigned og = xb_add(&bar[XB_TOP], 1u);
            const unsigned tg = og / nx;
            if (og + 1u == (tg + 1u) * nx) xb_add(&bar[XB_TOPGEN], 1u);
            else XB_SPIN(xb_ld(&bar[XB_TOPGEN]) == tg, bar);
            __builtin_amdgcn_fence(__ATOMIC_ACQUIRE, "agent");
            xb_add(&bar[XB_XGEN(b.x)], 1u);
            asm volatile("s_waitcnt vmcnt(0)" ::: "memory");
        } else {
            XB_SPIN(xb_ld(&bar[XB_XGEN(b.x)]) == gen, bar);
            __builtin_amdgcn_fence(__ATOMIC_ACQUIRE, "agent");
            asm volatile("s_waitcnt vmcnt(0)" ::: "memory");
        }
    }
    __syncthreads();
}

struct Ctx { unsigned char* ws; const float* xp; const float* xs; float* out; int G, c; };

template <bool F16 = false, class F> __device__ __forceinline__ void epi_store_bf16(const f32x4 (&acc)[2][2][4][2], bf16_t* tile  , size_t ldc, const F& f) {
#pragma unroll
    for (int ai = 0; ai < 2; ++ai)
#pragma unroll
        for (int m = 0; m < 4; ++m) { bf16_t* rowp = tile + (size_t)(ai * 128 + m * 16) * ldc;
#pragma unroll
            for (int bj = 0; bj < 2; ++bj) { f32x4 v0 = acc[ai][bj][m][0], v1 = acc[ai][bj][m][1];
                f(v0, v1, bj, ai * 128 + m * 16);
                u32x4 w;
                if (F16) { w.x = cvt_pk_f16(v0[0], v0[1]); w.y = cvt_pk_f16(v0[2], v0[3]); w.z = cvt_pk_f16(v1[0], v1[1]); w.w = cvt_pk_f16(v1[2], v1[3]); }
                else { w.x = cvt_pk_bf16(v0[0], v0[1]); w.y = cvt_pk_bf16(v0[2], v0[3]); w.z = cvt_pk_bf16(v1[0], v1[1]); w.w = cvt_pk_bf16(v1[2], v1[3]); }
                *(u32x4*)(rowp + bj * 128) = w; } }
}
struct FIdent { __device__ __forceinline__ void operator()(f32x4&, f32x4&, int, int) const {} };
struct FSilu { float s; __device__ __forceinline__ void operator()(f32x4& a, f32x4& b, int, int) const {
#pragma unroll
    for (int e = 0; e < 4; ++e) { a[e] = fsilu(a[e]) * s; b[e] = fsilu(b[e]) * s; } } };
struct FLogF { f32x4 lb[2][2]; __device__ __forceinline__ void operator()(f32x4& a, f32x4& b, int bj, int) const {
#pragma unroll
    for (int e = 0; e < 4; ++e) { const float l0 = lb[bj][0][e], l1 = lb[bj][1][e];
        a[e] = l0 + (1.f - l0) * fsig(a[e]); b[e] = l1 + (1.f - l1) * fsig(b[e]); } } };

struct ProbG1a {
    static constexpr bool PERM = true;
    pg8::StaticOrder S; int lda, ldb, nt; unsigned char* ws;
    __device__ __forceinline__ void init(const Ctx& c) { S.init(TOK, 20480, c.G, c.c); lda = D; ldb = D; nt = D / 64; ws = c.ws; }
    __device__ __forceinline__ bool next(int i, pg8::Unit& u) const { return S.next(i, u); }
    __device__ __forceinline__ void ptrs(const pg8::Unit& u, pg8::Ptrs& q) const {
        q.a0 = (const char*)(ws + WS_H) + (size_t)u.pm * 256 * D * 2; q.a1 = q.a0 + (size_t)128 * D * 2;
        q.b0 = (const char*)(ws + WS_WIN) + (size_t)u.pn * 256 * D * 2; q.b1 = q.b0 + (size_t)128 * D * 2; }
    __device__ __forceinline__ void epi(const f32x4 (&acc)[2][2][4][2], const pg8::Unit& u, int wr, int wc, int fr, int fq) const {
        const int seg = u.pn >> 4, colt = (u.pn & 15) * 256 + wc * 32 + 8 * fq, row0 = u.pm * 256 + wr * 64 + fr;
        bf16_t* tile = (bf16_t*)(ws + WS_Q + (size_t)seg * 256 * MiB) + (size_t)row0 * D + colt;
        if (seg == 0) { FSilu f{0.08838834764831845f}; epi_store_bf16(acc, tile, D, f); }
        else if (seg == 1 || seg == 2) { const float* lb = (const float*)(ws + (seg == 1 ? WS_LBF : WS_LBB)) + colt; FLogF f;
#pragma unroll
            for (int bj = 0; bj < 2; ++bj)
#pragma unroll
                for (int n = 0; n < 2; ++n) f.lb[bj][n] = *(const f32x4*)(lb + bj * 128 + 4 * n);
            epi_store_bf16<true>(acc, tile, D, f); }
        else if (seg == 3) { FIdent f; epi_store_bf16(acc, tile, D, f); }
        else { FSilu f{1.f}; epi_store_bf16(acc, tile, D, f); }
    }
};
struct ProbPlain {
    static constexpr bool PERM = true;
    pg8::StaticOrder S; int lda, ldb, nt; const char* A; const char* B; bf16_t* C; int ldc;
    __device__ __forceinline__ void init(const Ctx& c, const void* A_, const void* B_, void* C_, int N, int K) { S.init(TOK, N, c.G, c.c); lda = K; ldb = K; nt = K / 64; A = (const char*)A_; B = (const char*)B_; C = (bf16_t*)C_; ldc = N; }
    __device__ __forceinline__ bool next(int i, pg8::Unit& u) const { return S.next(i, u); }
    __device__ __forceinline__ void ptrs(const pg8::Unit& u, pg8::Ptrs& q) const {
        q.a0 = A + (size_t)u.pm * 256 * lda * 2; q.a1 = q.a0 + (size_t)128 * lda * 2; q.b0 = B + (size_t)u.pn * 256 * ldb * 2; q.b1 = q.b0 + (size_t)128 * ldb * 2; }
    __device__ __forceinline__ void epi(const f32x4 (&acc)[2][2][4][2], const pg8::Unit& u, int wr, int wc, int fr, int fq) const {
        bf16_t* tile = C + (size_t)(u.pm * 256 + wr * 64 + fr) * ldc + u.pn * 256 + wc * 32 + 8 * fq; FIdent f; epi_store_bf16(acc, tile, ldc, f); }
};
struct ProbG1b {
    static constexpr bool PERM = true;
    pg8::StaticOrder S; int lda, ldb, nt; unsigned char* ws;
    __device__ __forceinline__ void init(const Ctx& c) { S.init(TOK, 4096, c.G, c.c); lda = D; ldb = D; nt = D / 64; ws = c.ws; }
    __device__ __forceinline__ bool next(int i, pg8::Unit& u) const { return S.next(i, u); }
    __device__ __forceinline__ void ptrs(const pg8::Unit& u, pg8::Ptrs& q) const {
        q.a0 = (const char*)(ws + WS_H) + (size_t)u.pm * 256 * D * 2; q.a1 = q.a0 + (size_t)128 * D * 2;
        q.b0 = (const char*)(ws + WS_WIN) + (size_t)(C_U + u.pn * 256) * D * 2; q.b1 = q.b0 + (size_t)128 * D * 2; }
    __device__ __forceinline__ void epi(const f32x4 (&acc)[2][2][4][2], const pg8::Unit& u, int wr, int wc, int fr, int fq) const {
        const int seg = u.pn >> 3, colt = (u.pn & 7) * 256 + wc * 32 + 8 * fq, row0 = u.pm * 256 + wr * 64 + fr;
        bf16_t* tile = (bf16_t*)(ws + (seg ? WS_SGB : WS_U)) + (size_t)row0 * DB + colt;
        if (seg == 0) { FIdent f; epi_store_bf16(acc, tile, DB, f); } else { FSilu f{1.f}; epi_store_bf16(acc, tile, DB, f); }
    }
};
struct ProbDft1 {
    static constexpr bool PERM = true;
    pg8::StaticOrder S; int lda, ldb, nt; unsigned char* ws;
    __device__ __forceinline__ void init(const Ctx& c) { S.init(4096, TOK, c.G, c.c); lda = CG; ldb = DB; nt = CG / 64; ws = c.ws; }
    __device__ __forceinline__ bool next(int i, pg8::Unit& u) const { return S.next(i, u); }
    __device__ __forceinline__ void ptrs(const pg8::Unit& u, pg8::Ptrs& q) const {
        const int g = u.pm >> 2, pmr = u.pm & 3;
        q.a0 = (const char*)(ws + WS_DFTC) + (size_t)pmr * 256 * CG * 2; q.a1 = q.a0 + (size_t)128 * CG * 2;
        q.b0 = (const char*)(ws + WS_U) + ((size_t)u.pn * 256 * DB + (size_t)g * CG) * 2; q.b1 = q.b0 + (size_t)128 * DB * 2; }
    __device__ __forceinline__ void epi(const f32x4 (&acc)[2][2][4][2], const pg8::Unit& u, int wr, int wc, int fr, int fq) const {
        const int g = u.pm >> 2, pmr = u.pm & 3, part = pmr >> 1, j0 = (pmr & 1) * 256 + wr * 64 + fr;
        const int tt = u.pn; size_t base; int L, l0;
        if (tt < 64) { L = LP; base = (size_t)(tt >> 5) * 2048 * (2 * LP); l0 = (tt & 31) * 256; }
        else { const int ts = tt - 64; L = LSQ; base = ABT_SAMPLE_OFF + (size_t)(ts >> 3) * 2048 * (2 * LSQ); l0 = (ts & 7) * 256; }
        bf16_t* tile = (bf16_t*)(ws + WS_ABT) + base + (size_t)(g * CG + j0) * (2 * L) + (size_t)part * L + l0 + wc * 32 + 8 * fq;
        FIdent f; epi_store_bf16(acc, tile, (size_t)2 * L, f);
    }
};
struct FMulG { const bf16_t* g; __device__ __forceinline__ void operator()(f32x4& a, f32x4& b, int bj, int roff) const {
    const u32x4 w = *(const u32x4*)(g + (size_t)roff * DB + bj * 128);
    a[0] *= bf_lo(w.x); a[1] *= bf_hi(w.x); a[2] *= bf_lo(w.y); a[3] *= bf_hi(w.y); b[0] *= bf_lo(w.z); b[1] *= bf_hi(w.z); b[2] *= bf_lo(w.w); b[3] *= bf_hi(w.w); } };
struct ProbDft2 {
    static constexpr bool PERM = true;
    pg8::StaticOrder S; int lda, ldb, nt; unsigned char* ws; int L, lshift; size_t abt_off, dfts_off; int tok0;
    __device__ __forceinline__ void init(const Ctx& c, int sample) { S.init(16384, DB, c.G, c.c); ws = c.ws;
        if (!sample) { L = LP; lshift = 5; abt_off = 0; dfts_off = WS_DFTS8; tok0 = 0; } else { L = LSQ; lshift = 3; abt_off = ABT_SAMPLE_OFF; dfts_off = WS_DFTS2; tok0 = NPT; }
        lda = 2 * L; ldb = 2 * L; nt = 2 * L / 64; }
    __device__ __forceinline__ bool next(int i, pg8::Unit& u) const { return S.next(i, u); }
    __device__ __forceinline__ void ptrs(const pg8::Unit& u, pg8::Ptrs& q) const {
        const int b = u.pm >> lshift, pml = u.pm & ((1 << lshift) - 1);
        q.a0 = (const char*)(ws + dfts_off) + (size_t)pml * 256 * (2 * L) * 2; q.a1 = q.a0 + (size_t)128 * (2 * L) * 2;
        q.b0 = (const char*)(ws + WS_ABT) + (abt_off + (size_t)b * 2048 * (2 * L) + (size_t)u.pn * 256 * (2 * L)) * 2; q.b1 = q.b0 + (size_t)128 * (2 * L) * 2; }
    __device__ __forceinline__ void epi(const f32x4 (&acc)[2][2][4][2], const pg8::Unit& u, int wr, int wc, int fr, int fq) const {
        const size_t off = (size_t)(tok0 + u.pm * 256 + wr * 64 + fr) * DB + u.pn * 256 + wc * 32 + 8 * fq;
        FMulG f{(const bf16_t*)(ws + WS_SGB) + off}; epi_store_bf16(acc, (bf16_t*)(ws + WS_BOUT) + off, DB, f);
    }
};
struct ProbMerge {
    static constexpr bool PERM = true;
    pg8::StaticOrder S; int lda, ldb, nt; unsigned char* ws;
    __device__ __forceinline__ void init(const Ctx& c) { S.init(TOK, 8192, c.G, c.c); lda = D; ldb = D; nt = D / 64; ws = c.ws; }
    __device__ __forceinline__ bool next(int i, pg8::Unit& u) const { return S.next(i, u); }
    __device__ __forceinline__ void ptrs(const pg8::Unit& u, pg8::Ptrs& q) const {
        q.a0 = (const char*)(ws + WS_H) + (size_t)u.pm * 256 * D * 2; q.a1 = q.a0 + (size_t)128 * D * 2;
        q.b0 = (const char*)(ws + WS_WIN) + (size_t)(C_MA + u.pn * 128) * D * 2; q.b1 = (const char*)(ws + WS_WIN) + (size_t)(C_MB + u.pn * 128) * D * 2; }
    __device__ __forceinline__ void epi(const f32x4 (&acc)[2][2][4][2], const pg8::Unit& u, int wr, int wc, int fr, int fq) const {
        const size_t off0 = (size_t)(u.pm * 256 + wr * 64 + fr) * D + u.pn * 128 + wc * 32 + 8 * fq;
        const bf16_t* pa = (const bf16_t*)(ws + WS_PA) + off0; const bf16_t* pb = (const bf16_t*)(ws + WS_PB) + off0; bf16_t* mo = (bf16_t*)(ws + WS_M) + off0;
#pragma unroll
        for (int ai = 0; ai < 2; ++ai)
#pragma unroll
            for (int m = 0; m < 4; ++m) { const size_t ro = (size_t)(ai * 128 + m * 16) * D;
                const u32x4 wa = *(const u32x4*)(pa + ro), wb = *(const u32x4*)(pb + ro);
                const f32x4 a0 = acc[ai][0][m][0], a1 = acc[ai][0][m][1], b0 = acc[ai][1][m][0], b1 = acc[ai][1][m][1];
                float r[8];
                r[0] = fsig(a0[0]) * bf_lo(wa.x) + fsig(b0[0]) * bf_lo(wb.x); r[1] = fsig(a0[1]) * bf_hi(wa.x) + fsig(b0[1]) * bf_hi(wb.x);
                r[2] = fsig(a0[2]) * bf_lo(wa.y) + fsig(b0[2]) * bf_lo(wb.y); r[3] = fsig(a0[3]) * bf_hi(wa.y) + fsig(b0[3]) * bf_hi(wb.y);
                r[4] = fsig(a1[0]) * bf_lo(wa.z) + fsig(b1[0]) * bf_lo(wb.z); r[5] = fsig(a1[1]) * bf_hi(wa.z) + fsig(b1[1]) * bf_hi(wb.z);
                r[6] = fsig(a1[2]) * bf_lo(wa.w) + fsig(b1[2]) * bf_lo(wb.w); r[7] = fsig(a1[3]) * bf_hi(wa.w) + fsig(b1[3]) * bf_hi(wb.w);
                u32x4 w; w.x = cvt_pk_bf16(r[0], r[1]); w.y = cvt_pk_bf16(r[2], r[3]); w.z = cvt_pk_bf16(r[4], r[5]); w.w = cvt_pk_bf16(r[6], r[7]);
                *(u32x4*)(mo + ro) = w; }
    }
};
struct ProbOut {
    static constexpr bool PERM = false;
    pg8::StaticOrder S; int lda, ldb, nt; unsigned char* ws; const float* xp; const float* xs; float* out;
    __device__ __forceinline__ void init(const Ctx& c) { S.init(TOK, D, c.G, c.c); lda = D; ldb = D; nt = D / 64; ws = c.ws; xp = c.xp; xs = c.xs; out = c.out; }
    __device__ __forceinline__ bool next(int i, pg8::Unit& u) const { return S.next(i, u); }
    __device__ __forceinline__ void ptrs(const pg8::Unit& u, pg8::Ptrs& q) const {
        q.a0 = (const char*)(ws + WS_M) + (size_t)u.pm * 256 * D * 2; q.a1 = q.a0 + (size_t)128 * D * 2;
        q.b0 = (const char*)(ws + WS_WO) + (size_t)u.pn * 256 * D * 2; q.b1 = q.b0 + (size_t)128 * D * 2; }
    __device__ __forceinline__ void epi(const f32x4 (&acc)[2][2][4][2], const pg8::Unit& u, int wr, int wc, int fr, int fq) const {
        const int row0 = u.pm * 256 + wr * 64 + fr, col0 = u.pn * 256 + wc * 32 + 4 * fq;
        const float* xb = (u.pm < 64) ? xp + (size_t)row0 * D : xs + (size_t)(row0 - NPT) * D;
        float* ob = out + (size_t)row0 * D;
#pragma unroll
        for (int ai = 0; ai < 2; ++ai)
#pragma unroll
            for (int m = 0; m < 4; ++m) { const size_t ro = (size_t)(ai * 128 + m * 16) * D + col0;
#pragma unroll
                for (int bj = 0; bj < 2; ++bj)
#pragma unroll
                    for (int n = 0; n < 2; ++n) { const f32x4 xv = *(const f32x4*)(xb + ro + bj * 128 + n * 16); *(f32x4*)(ob + ro + bj * 128 + n * 16) = acc[ai][bj][m][n] + xv; } }
    }
};

__device__ __forceinline__ unsigned f2bf(float f) { unsigned u = __builtin_bit_cast(unsigned, f); return (u + 0x7fffu + ((u >> 16) & 1u)) >> 16; }
__device__ __forceinline__ unsigned pk2(float lo, float hi) { return f2bf(lo) | (f2bf(hi) << 16); }
__device__ __forceinline__ void p0_transpose_item(const float* W, int K, int N, bf16_t* WT, LAS float* scr, int item, int lane) {
    const int nblk = N / 32, kb = item / nblk, nb = item % nblk, k0 = 64 * kb, n0 = 32 * nb;
#pragma unroll 8
    for (int i = 0; i < 32; ++i) { const int kk = 2 * i + (lane >> 5); scr[kk * 33 + (lane & 31)] = W[(size_t)(k0 + kk) * N + n0 + (lane & 31)]; }
    LDS_WAIT(); asm volatile("" ::: "memory");
    const int c = lane & 7;
#pragma unroll
    for (int j = 0; j < 4; ++j) { const int n = (lane >> 3) + 8 * j; const LAS float* s = scr + (8 * c) * 33 + n;
        u32x4 o; o.x = pk2(s[0 * 33], s[1 * 33]); o.y = pk2(s[2 * 33], s[3 * 33]); o.z = pk2(s[4 * 33], s[5 * 33]); o.w = pk2(s[6 * 33], s[7 * 33]);
        *(u32x4*)(WT + (size_t)(n0 + n) * K + k0 + 8 * c) = o; }
    LDS_WAIT(); asm volatile("" ::: "memory");
}
template <bool OUT_BF16> __device__ __forceinline__ void rms_row(const float* xrow, const float* g, void* orow, int lane) {
    const f32x4* xr = (const f32x4*)xrow + lane;
    f32x4 v[16]; float s = 0.f;
#pragma unroll
    for (int j = 0; j < 16; ++j) { v[j] = xr[64 * j]; s += (v[j].x * v[j].x + v[j].y * v[j].y) + (v[j].z * v[j].z + v[j].w * v[j].w); }
    const float rstd = 1.0f / sqrtf(wave_sum(s) * (1.f / D) + EPS);
    const f32x4* gr = (const f32x4*)g + lane;
#pragma unroll
    for (int j = 0; j < 16; ++j) { const f32x4 gv = gr[64 * j]; const f32x4 y = v[j] * rstd * gv;
        if (OUT_BF16) { u32x2 w; w.x = cvt_pk_bf16(y.x, y.y); w.y = cvt_pk_bf16(y.z, y.w); ((u32x2*)orow)[lane + 64 * j] = w; }
        else ((f32x4*)orow)[lane + 64 * j] = y; }
}

struct Args { const float* in[11]; float* out; unsigned char* ws; int ph_lo, ph_hi; };

__device__ __forceinline__ void gla_pair_info(int p, int& tok0, int& L, int& h) { h = p & 31; if (p < 64) { tok0 = (p >> 5) * LP; L = LP; } else { tok0 = NPT + ((p - 64) >> 5) * LSQ; L = LSQ; } }

#if GLA_NAIVE
__device__ __forceinline__ void gla_pair_naive(LAS unsigned char* lds, unsigned char* ws, const float* ghead, int p) {
    const int tid = threadIdx.x, lane = tid & 63, wave = tid >> 6;
    int tok0, L, h; gla_pair_info(p, tok0, L, h);
    const bf16_t* Q = (const bf16_t*)(ws + WS_Q); bf16_t* KF = (bf16_t*)(ws + WS_KF); const bf16_t* KB = (const bf16_t*)(ws + WS_KB);
    const bf16_t* V = (const bf16_t*)(ws + WS_V); bf16_t* GA = (bf16_t*)(ws + WS_GA);
    LAS float* Lq = (LAS float*)lds; LAS float* Lf = Lq + 16 * 128; LAS float* Lk = Lf + 16 * 128; LAS float* Lv = Lk + 16 * 128; LAS float* Lo = Lv + 16 * 128;
    const int v = tid & 127, kq = tid >> 7;
    for (int pass = 0; pass < 2; ++pass) {
        float S[32];
#pragma unroll
        for (int i = 0; i < 32; ++i) S[i] = 0.f;
        const bf16_t* F = pass ? KB : (const bf16_t*)KF;
        for (int blk = 0; blk < L / 16; ++blk) {
            { const int i = tid >> 5, c4 = (tid & 31) * 4; const int tau = blk * 16 + i; const int t = tok0 + (pass ? (L - 1 - tau) : tau);
              const size_t off = (size_t)t * D + h * DH + c4;
              const u32x2 wq = *(const u32x2*)(Q + off), wf = *(const u32x2*)(F + off), wv = *(const u32x2*)(V + off);
              const float lf0 = bf_lo(wf.x), lf1 = bf_hi(wf.x), lf2 = bf_lo(wf.y), lf3 = bf_hi(wf.y);
              const float f0 = fexp(lf0), f1 = fexp(lf1), f2 = fexp(lf2), f3 = fexp(lf3);
              *(LAS f32x4*)(Lq + i * 128 + c4) = (f32x4){bf_lo(wq.x), bf_hi(wq.x), bf_lo(wq.y), bf_hi(wq.y)};
              *(LAS f32x4*)(Lf + i * 128 + c4) = (f32x4){f0, f1, f2, f3};
              *(LAS f32x4*)(Lk + i * 128 + c4) = (f32x4){1.f - f0, 1.f - f1, 1.f - f2, 1.f - f3};
              *(LAS f32x4*)(Lv + i * 128 + c4) = (f32x4){bf_lo(wv.x), bf_hi(wv.x), bf_lo(wv.y), bf_hi(wv.y)}; }
            __syncthreads();
            for (int i = 0; i < 16; ++i) {
                const float vv = Lv[i * 128 + v]; float op = 0.f;
#pragma unroll
                for (int k4 = 0; k4 < 8; ++k4) {
                    const f32x4 f = *(const LAS f32x4*)(Lf + i * 128 + kq * 32 + k4 * 4), kx = *(const LAS f32x4*)(Lk + i * 128 + kq * 32 + k4 * 4), qx = *(const LAS f32x4*)(Lq + i * 128 + kq * 32 + k4 * 4);
#pragma unroll
                    for (int e = 0; e < 4; ++e) { S[k4 * 4 + e] = f[e] * S[k4 * 4 + e] + kx[e] * vv; op += S[k4 * 4 + e] * qx[e]; }
                }
                Lo[(i * 4 + kq) * 128 + v] = op;
            }
            __syncthreads();
#pragma unroll
            for (int j = 0; j < 2; ++j) { const int i = 2 * wave + j; const int tau = blk * 16 + i; const int t = tok0 + (pass ? (L - 1 - tau) : tau);
                const size_t off = (size_t)t * D + h * DH + 2 * lane;
                float o0 = 0.f, o1 = 0.f;
#pragma unroll
                for (int q = 0; q < 4; ++q) { const f32x2 x = *(const LAS f32x2*)(Lo + (i * 4 + q) * 128 + 2 * lane); o0 += x.x; o1 += x.y; }
                if (pass == 0) { *(unsigned*)(KF + off) = cvt_pk_bf16(o0, o1); }
                else { const unsigned wf = *(const unsigned*)(KF + off), wg = *(const unsigned*)(GA + off);
                    o0 += bf_lo(wf); o1 += bf_hi(wf);
                    const float ss = wave_sum(o0 * o0 + o1 * o1); const float rstd = 1.0f / sqrtf(ss * (1.f / DH) + EPS);
                    const f32x2 gh = *(const f32x2*)(ghead + h * DH + 2 * lane);
                    *(unsigned*)(GA + off) = cvt_pk_bf16(o0 * rstd * gh.x * bf_lo(wg), o1 * rstd * gh.y * bf_hi(wg)); }
            }
            __syncthreads();
        }
        VM_WAIT(); __syncthreads(); __builtin_amdgcn_fence(__ATOMIC_ACQUIRE, "agent"); VM_WAIT(); __syncthreads();
    }
}
#endif

constexpr int GL_QH = 0, GL_KT = 17408, GL_KTT = 34816, GL_VT = 53248, GL_ST = 71680, GL_SEG = 106496, GL_DV = 110592;
#define LBAR() do { asm volatile("s_waitcnt lgkmcnt(0)" ::: "memory"); __builtin_amdgcn_s_barrier(); asm volatile("" ::: "memory"); } while (0)
#define MFMA32(a, b, c) __builtin_amdgcn_mfma_f32_32x32x16_bf16((a), (b), (c), 0, 0, 0)
template <int PASS>
__device__ __forceinline__ void gla_pass(LAS unsigned char* lds, unsigned char* ws, const float* ghead, int tok0, int L, int h) {
    const int tid = threadIdx.x, lane = tid & 63, wave = __builtin_amdgcn_readfirstlane(tid >> 6);
    const int nchunk = L >> 6, tq = wave >> 2, vt = wave & 3, l31 = lane & 31, hh = lane >> 5;
    const size_t colo = (size_t)h * DH + 2 * lane;
    const bf16_t* Q = (const bf16_t*)(ws + WS_Q) + colo; const bf16_t* F = (const bf16_t*)(ws + (PASS ? WS_KB : WS_KF)) + colo; const bf16_t* V = (const bf16_t*)(ws + WS_V) + colo;
    const int er = lane >> 3, ec = (lane & 7) * 16;
    bf16_t* KFe = (bf16_t*)(ws + WS_KF) + (size_t)h * DH + ec; bf16_t* GAe = (bf16_t*)(ws + WS_GA) + (size_t)h * DH + ec;
    f32x4 ghv[4];
#pragma unroll
    for (int j = 0; j < 4; ++j) ghv[j] = *(const f32x4*)(ghead + h * DH + ec + 4 * j);
    const long stp = PASS ? -1 : 1;
    f32x16 s0, s1;
#pragma unroll
    for (int i = 0; i < 16; ++i) { s0[i] = 0.f; s1[i] = 0.f; }
    for (int i = tid; i < 34816 / 16; i += 512) ((LAS u32x4*)(lds + GL_ST))[i] = (u32x4){0u, 0u, 0u, 0u};
    unsigned cq[8], cf[8], cv[8];
    { const int tau0 = 8 * wave; const long t0 = tok0 + (PASS ? (L - 1 - tau0) : tau0);
#pragma unroll
      for (int i = 0; i < 8; ++i) { const size_t ro = (size_t)(t0 + stp * i) * D; cq[i] = *(const unsigned*)(Q + ro); cf[i] = *(const unsigned*)(F + ro); cv[i] = *(const unsigned*)(V + ro); } }
    for (int c = 0; c < nchunk; ++c) {
        const int tau0 = 64 * c + 8 * wave; const long t0 = tok0 + (PASS ? (L - 1 - tau0) : tau0);
        const int adv = (c + 1 < nchunk) ? 64 : 0;
        unsigned nq[8], nf[8], nv[8];
#pragma unroll
        for (int i = 0; i < 8; ++i) { const size_t ro = (size_t)(t0 + stp * (adv + i)) * D; nq[i] = *(const unsigned*)(Q + ro); nf[i] = *(const unsigned*)(F + ro); nv[i] = *(const unsigned*)(V + ro); }
        const size_t ero = (size_t)(t0 + stp * er) * D;
        u32x4 wof[2], wga[2];
        if (PASS) { wof[0] = *(const u32x4*)(KFe + ero); wof[1] = *(const u32x4*)(KFe + ero + 8); wga[0] = *(const u32x4*)(GAe + ero); wga[1] = *(const u32x4*)(GAe + ero + 8); }
        float f0[8], f1[8], e0[8], e1[8]; { float r0 = 1.f, r1 = 1.f;
#pragma unroll
            for (int i = 0; i < 8; ++i) { const f32x2 fv = unpk_f16(cf[i]); f0[i] = fv.x; f1[i] = fv.y; r0 *= fv.x; r1 *= fv.y; e0[i] = r0; e1[i] = r1; }
            *(LAS f32x2*)(lds + GL_SEG + (wave * 128 + 2 * lane) * 4) = (f32x2){r0, r1}; }
        LBAR();
        { float p0 = 1.f, p1 = 1.f;
#pragma unroll
          for (int w = 0; w < 7; ++w) if (w < wave) { const f32x2 x = *(const LAS f32x2*)(lds + GL_SEG + (w * 128 + 2 * lane) * 4); p0 *= x.x; p1 *= x.y; }
          unsigned kc0[4], kc1[4], vc0[4], vc1[4]; float kp0 = 0.f, kp1 = 0.f;
#pragma unroll
          for (int i = 0; i < 8; ++i) { const float ee0 = e0[i] * p0, ee1 = e1[i] * p1;
              const float q0 = bf_lo(cq[i]) * ee0, q1 = bf_hi(cq[i]) * ee1;
              const float k0 = (1.f - f0[i]) * frcp(ee0), k1 = (1.f - f1[i]) * frcp(ee1);
              *(LAS unsigned*)(lds + GL_QH + (8 * wave + i) * 272 + 4 * lane) = cvt_pk_bf16(q0, q1);
              *(LAS unsigned*)(lds + GL_KT + (8 * wave + i) * 272 + 4 * lane) = cvt_pk_bf16(k0, k1);
              if (i & 1) { kc0[i >> 1] = cvt_pk_bf16(kp0, k0); kc1[i >> 1] = cvt_pk_bf16(kp1, k1); vc0[i >> 1] = (cv[i - 1] & 0xffffu) | (cv[i] << 16); vc1[i >> 1] = (cv[i - 1] >> 16) | (cv[i] & 0xffff0000u); }
              else { kp0 = k0; kp1 = k1; } }
          if (wave == 7) *(LAS f32x2*)(lds + GL_DV + 2 * lane * 4) = (f32x2){e0[7] * p0, e1[7] * p1};
          *(LAS u32x4*)(lds + GL_KTT + (2 * lane) * 144 + 16 * wave) = (u32x4){kc0[0], kc0[1], kc0[2], kc0[3]};
          *(LAS u32x4*)(lds + GL_KTT + (2 * lane + 1) * 144 + 16 * wave) = (u32x4){kc1[0], kc1[1], kc1[2], kc1[3]};
          *(LAS u32x4*)(lds + GL_VT + (2 * lane) * 144 + 16 * wave) = (u32x4){vc0[0], vc0[1], vc0[2], vc0[3]};
          *(LAS u32x4*)(lds + GL_VT + (2 * lane + 1) * 144 + 16 * wave) = (u32x4){vc1[0], vc1[1], vc1[2], vc1[3]}; }
        LBAR();
        f32x16 oacc;
#pragma unroll
        for (int i = 0; i < 16; ++i) oacc[i] = 0.f;
        bf16x8 qf[8];
#pragma unroll
        for (int ks = 0; ks < 8; ++ks) qf[ks] = *(const LAS bf16x8*)(lds + GL_QH + (32 * tq + l31) * 272 + hh * 16 + ks * 32);
#pragma unroll
        for (int ks = 0; ks < 8; ++ks) { const bf16x8 sb = *(const LAS bf16x8*)(lds + GL_ST + (32 * vt + l31) * 272 + hh * 16 + ks * 32); oacc = MFMA32(qf[ks], sb, oacc); }
        for (int st = 0; st <= tq; ++st) {
            f32x16 x;
#pragma unroll
            for (int i = 0; i < 16; ++i) x[i] = 0.f;
#pragma unroll
            for (int ks = 0; ks < 8; ++ks) { const bf16x8 ka = *(const LAS bf16x8*)(lds + GL_KT + (32 * st + l31) * 272 + hh * 16 + ks * 32); x = MFMA32(ka, qf[ks], x); }
            if (st == tq) {
#pragma unroll
                for (int r = 0; r < 16; ++r) { const int sl = (r & 3) + 8 * (r >> 2) + 4 * hh; x[r] = (sl <= l31) ? x[r] : 0.f; }
            }
#pragma unroll
            for (int sp = 0; sp < 2; ++sp) {
                u32x4 aw; aw.x = cvt_pk_bf16(x[8 * sp + 0], x[8 * sp + 1]); aw.y = cvt_pk_bf16(x[8 * sp + 2], x[8 * sp + 3]); aw.z = cvt_pk_bf16(x[8 * sp + 4], x[8 * sp + 5]); aw.w = cvt_pk_bf16(x[8 * sp + 6], x[8 * sp + 7]);
                const LAS unsigned char* vp = lds + GL_VT + (32 * vt + l31) * 144 + 64 * st + 32 * sp + 8 * hh;
                const u32x2 blo = *(const LAS u32x2*)vp, bhi = *(const LAS u32x2*)(vp + 16);
                const u32x4 bw = (u32x4){blo.x, blo.y, bhi.x, bhi.y};
                oacc = MFMA32(__builtin_bit_cast(bf16x8, aw), __builtin_bit_cast(bf16x8, bw), oacc);
            }
        }
#pragma unroll
        for (int ks = 0; ks < 4; ++ks) { const bf16x8 vb = *(const LAS bf16x8*)(lds + GL_VT + (32 * vt + l31) * 144 + hh * 16 + ks * 32);
            const bf16x8 ka0 = *(const LAS bf16x8*)(lds + GL_KTT + (64 * tq + l31) * 144 + hh * 16 + ks * 32), ka1 = *(const LAS bf16x8*)(lds + GL_KTT + (64 * tq + 32 + l31) * 144 + hh * 16 + ks * 32);
            s0 = MFMA32(ka0, vb, s0); s1 = MFMA32(ka1, vb, s1); }
#pragma unroll
        for (int g = 0; g < 4; ++g) { const f32x4 d0 = *(const LAS f32x4*)(lds + GL_DV + (64 * tq + 8 * g + 4 * hh) * 4), d1 = *(const LAS f32x4*)(lds + GL_DV + (64 * tq + 32 + 8 * g + 4 * hh) * 4);
#pragma unroll
            for (int e = 0; e < 4; ++e) { s0[4 * g + e] *= d0[e]; s1[4 * g + e] *= d1[e]; } }
        LBAR();
#pragma unroll
        for (int r = 0; r < 16; ++r) { const int tl = (r & 3) + 8 * (r >> 2) + 4 * hh; *(LAS float*)(lds + ((32 * tq + tl) * 132 + 32 * vt + l31) * 4) = oacc[r]; }
#pragma unroll
        for (int g = 0; g < 4; ++g) {
            *(LAS u32x2*)(lds + GL_ST + (32 * vt + l31) * 272 + (64 * tq + 8 * g + 4 * hh) * 2) = (u32x2){cvt_pk_bf16(s0[4 * g], s0[4 * g + 1]), cvt_pk_bf16(s0[4 * g + 2], s0[4 * g + 3])};
            *(LAS u32x2*)(lds + GL_ST + (32 * vt + l31) * 272 + (64 * tq + 32 + 8 * g + 4 * hh) * 2) = (u32x2){cvt_pk_bf16(s1[4 * g], s1[4 * g + 1]), cvt_pk_bf16(s1[4 * g + 2], s1[4 * g + 3])}; }
        LBAR();
        { f32x4 o4[4];
#pragma unroll
          for (int j = 0; j < 4; ++j) o4[j] = *(const LAS f32x4*)(lds + ((8 * wave + er) * 132 + ec + 4 * j) * 4);
          if (PASS == 0) {
              u32x4 w0, w1; w0.x = cvt_pk_bf16(o4[0].x, o4[0].y); w0.y = cvt_pk_bf16(o4[0].z, o4[0].w); w0.z = cvt_pk_bf16(o4[1].x, o4[1].y); w0.w = cvt_pk_bf16(o4[1].z, o4[1].w);
              w1.x = cvt_pk_bf16(o4[2].x, o4[2].y); w1.y = cvt_pk_bf16(o4[2].z, o4[2].w); w1.z = cvt_pk_bf16(o4[3].x, o4[3].y); w1.w = cvt_pk_bf16(o4[3].z, o4[3].w);
              *(u32x4*)(KFe + ero) = w0; *(u32x4*)(KFe + ero + 8) = w1;
          } else {
              o4[0] += (f32x4){bf_lo(wof[0].x), bf_hi(wof[0].x), bf_lo(wof[0].y), bf_hi(wof[0].y)}; o4[1] += (f32x4){bf_lo(wof[0].z), bf_hi(wof[0].z), bf_lo(wof[0].w), bf_hi(wof[0].w)};
              o4[2] += (f32x4){bf_lo(wof[1].x), bf_hi(wof[1].x), bf_lo(wof[1].y), bf_hi(wof[1].y)}; o4[3] += (f32x4){bf_lo(wof[1].z), bf_hi(wof[1].z), bf_lo(wof[1].w), bf_hi(wof[1].w)};
              float ss = 0.f;
#pragma unroll
              for (int j = 0; j < 4; ++j) ss += (o4[j].x * o4[j].x + o4[j].y * o4[j].y) + (o4[j].z * o4[j].z + o4[j].w * o4[j].w);
              ss += __shfl_xor(ss, 1); ss += __shfl_xor(ss, 2); ss += __shfl_xor(ss, 4);
              const float rstd = 1.0f / sqrtf(ss * (1.f / DH) + EPS);
#pragma unroll
              for (int j = 0; j < 4; ++j) o4[j] = o4[j] * rstd * ghv[j];
              u32x4 w0, w1;
              w0.x = cvt_pk_bf16(o4[0].x * bf_lo(wga[0].x), o4[0].y * bf_hi(wga[0].x)); w0.y = cvt_pk_bf16(o4[0].z * bf_lo(wga[0].y), o4[0].w * bf_hi(wga[0].y));
              w0.z = cvt_pk_bf16(o4[1].x * bf_lo(wga[0].z), o4[1].y * bf_hi(wga[0].z)); w0.w = cvt_pk_bf16(o4[1].z * bf_lo(wga[0].w), o4[1].w * bf_hi(wga[0].w));
              w1.x = cvt_pk_bf16(o4[2].x * bf_lo(wga[1].x), o4[2].y * bf_hi(wga[1].x)); w1.y = cvt_pk_bf16(o4[2].z * bf_lo(wga[1].y), o4[2].w * bf_hi(wga[1].y));
              w1.z = cvt_pk_bf16(o4[3].x * bf_lo(wga[1].z), o4[3].y * bf_hi(wga[1].z)); w1.w = cvt_pk_bf16(o4[3].z * bf_lo(wga[1].w), o4[3].w * bf_hi(wga[1].w));
              *(u32x4*)(GAe + ero) = w0; *(u32x4*)(GAe + ero + 8) = w1;
          } }
#pragma unroll
        for (int i = 0; i < 8; ++i) { asm volatile("" : "+v"(nq[i]), "+v"(nf[i]), "+v"(nv[i])); cq[i] = nq[i]; cf[i] = nf[i]; cv[i] = nv[i]; }
    }
    VM_WAIT(); __syncthreads(); __builtin_amdgcn_fence(__ATOMIC_ACQUIRE, "agent"); VM_WAIT(); __syncthreads();
}
__device__ __forceinline__ void gla_pair_mfma(LAS unsigned char* lds, unsigned char* ws, const float* ghead, int p) {
    int tok0, L, h; gla_pair_info(p, tok0, L, h);
    gla_pass<0>(lds, ws, ghead, tok0, L, h);
    gla_pass<1>(lds, ws, ghead, tok0, L, h);
}

__device__ __forceinline__ void gla_phase(LAS unsigned char* lds, unsigned char* ws, const float* ghead, int vcu, int G) {
#if GLA_NAIVE
#define GLA_PAIR gla_pair_naive
#else
#define GLA_PAIR gla_pair_mfma
#endif
    if (G == 256) { GLA_PAIR(lds, ws, ghead, vcu); if (vcu >= 64 && vcu < 128) GLA_PAIR(lds, ws, ghead, vcu + 192); }
    else { for (int p = vcu; p < 320; p += G) GLA_PAIR(lds, ws, ghead, p); }
}

__device__ __forceinline__ void p0_body(const Args& args, unsigned char* ws, LAS unsigned char* lds, int G, int bx, int tid, int lane, int wave, int gw, int NGW) {
        LAS float* scr = (LAS float*)(lds + wave * 16384);
        const float* w_in = args.in[3]; const float* w_a = args.in[7]; const float* w_b = args.in[8]; const float* w_o = args.in[9];
        constexpr int I_IN = (D / 64) * (32768 / 32), I_A = (D / 64) * (D / 32), I_B = (DB / 64) * (D / 32), I_O = I_A;
        for (int it = gw; it < I_IN + I_A + I_B + I_O; it += NGW) {
            int r = it;
            if (r < I_IN) { p0_transpose_item(w_in, D, 32768, (bf16_t*)(ws + WS_WIN), scr, r, lane); continue; } r -= I_IN;
            if (r < I_A) { p0_transpose_item(w_a, D, D, (bf16_t*)(ws + WS_WA), scr, r, lane); continue; } r -= I_A;
            if (r < I_B) { p0_transpose_item(w_b, DB, D, (bf16_t*)(ws + WS_WB), scr, r, lane); continue; } r -= I_B;
            p0_transpose_item(w_o, D, D, (bf16_t*)(ws + WS_WO), scr, r, lane);
        }
        for (int m = gw; m < TOK; m += NGW) { const float* xr = (m < NPT) ? args.in[0] + (size_t)m * D : args.in[1] + (size_t)(m - NPT) * D;
            rms_row<true>(xr, args.in[2], (bf16_t*)(ws + WS_H) + (size_t)m * D, lane); }
        for (int i = bx * 512 + tid; i < 2 * D; i += G * 512) { const float* lbp = (i < D) ? args.in[4] : args.in[5]; const int c = i & (D - 1);
            const float a0 = lbp[c], a1 = lbp[D + c]; ((float*)(ws + (i < D ? WS_LBF : WS_LBB)))[c] = 1.0f / (1.0f + expf(a1 - a0)); }
        for (int i = bx * 512 + tid; i < 1024 * 512; i += G * 512) { const int r = i >> 9, c = i & 511, j = r & 511, part = r >> 9; const float ph = (float)((j * c) & 511) * (1.f / 512.f);
            const float vv = (part ? __builtin_amdgcn_sinf(ph) : __builtin_amdgcn_cosf(ph)) * 0.04419417382415922f; ((bf16_t*)(ws + WS_DFTC))[i] = (bf16_t)f2bf(vv); }
        }

__global__ void __launch_bounds__(NWAVES * 64, 2) fwd_kernel(Args args) {
    extern __shared__ __attribute__((aligned(16))) unsigned char lds_raw[];
    LAS unsigned char* lds = (LAS unsigned char*)lds_raw;
    volatile LAS unsigned* MISC = (volatile LAS unsigned*)(lds + MISC_OFF);
    const int tid = threadIdx.x, lane = tid & 63, wave = __builtin_amdgcn_readfirstlane(tid >> 6);
    const int G = gridDim.x; const int bx = blockIdx.x; const int vcu = (G % 8 == 0) ? (bx % 8) * (G / 8) + bx / 8 : bx;
    unsigned char* ws = args.ws;
    unsigned* ctl = (unsigned*)(ws + WS_CTL);
    for (int u = tid; u < (LDS_BYTES - LDSCTL_OFF) / 4; u += NWAVES * 64) ((LAS unsigned*)(lds + LDSCTL_OFF))[u] = 0u;
    __syncthreads();
    XcdBarrier bar; bar.bar = ctl + CW_BAR; bar.x = 0; bar.st = nullptr;
    if (MK_N_LAUNCHES == 1) bar = xcd_barrier_post(ctl + CW_BAR, MISC + 8);
    const int lo = args.ph_lo, hi = args.ph_hi;
#define IN(k) (lo <= (k) && (k) < hi)
#define BOTH(k) (IN(k) && IN((k) + 1))
#define RPT(k, ...) do { { __VA_ARGS__ } if constexpr (REP[k] > 1) { __VA_ARGS__ } } while (0);
#define GRID_BAR() do { if (MK_N_LAUNCHES == 1) xcd_barrier(bar); } while (0)
    Ctx cx; cx.ws = ws; cx.xp = args.in[0]; cx.xs = args.in[1]; cx.out = args.out; cx.G = G; cx.c = bx;
    const int gw = vcu * NWAVES + wave, NGW = G * NWAVES;

    if (IN(0)) { RPT(0, p0_body(args, ws, lds, G, bx, tid, lane, wave, gw, NGW);)
        if (BOTH(0)) GRID_BAR();
    }
    if (IN(1)) { RPT(1, ProbG1a P; P.init(cx); pg8::gemm_phase(lds, P);) if (BOTH(1)) GRID_BAR(); }
    if (IN(2)) { gla_phase(lds, ws, args.in[6], vcu, G); if (BOTH(2)) GRID_BAR(); }
    if (IN(3)) { {
        RPT(3, { ProbPlain P; P.init(cx, ws + WS_GA, ws + WS_WA, ws + WS_PA, D, D); pg8::gemm_phase(lds, P); }
        { ProbG1b P; P.init(cx); pg8::gemm_phase(lds, P); })
        for (size_t i = ((size_t)bx * 512 + tid) * 2; i < (size_t)LP * 2 * LP; i += (size_t)G * 1024) { const int lp = (int)(i >> 14), kk = (int)(i & 16383), part = kk >> 13, l = kk & 8191;
            const float p0 = (float)((lp * l) & 8191) * (1.f / 8192.f), p1 = (float)((lp * (l + 1)) & 8191) * (1.f / 8192.f); const float sc = 0.011048543456039806f;
            const float v0 = part ? -__builtin_amdgcn_sinf(p0) : __builtin_amdgcn_cosf(p0), v1 = part ? -__builtin_amdgcn_sinf(p1) : __builtin_amdgcn_cosf(p1);
            *(unsigned*)((bf16_t*)(ws + WS_DFTS8) + i) = cvt_pk_bf16(v0 * sc, v1 * sc); }
        for (size_t i = ((size_t)bx * 512 + tid) * 2; i < (size_t)LSQ * 2 * LSQ; i += (size_t)G * 1024) { const int lp = (int)(i >> 12), kk = (int)(i & 4095), part = kk >> 11, l = kk & 2047;
            const float p0 = (float)((lp * l) & 2047) * (1.f / 2048.f), p1 = (float)((lp * (l + 1)) & 2047) * (1.f / 2048.f); const float sc = 0.022097086912079608f;
            const float v0 = part ? -__builtin_amdgcn_sinf(p0) : __builtin_amdgcn_cosf(p0), v1 = part ? -__builtin_amdgcn_sinf(p1) : __builtin_amdgcn_cosf(p1);
            *(unsigned*)((bf16_t*)(ws + WS_DFTS2) + i) = cvt_pk_bf16(v0 * sc, v1 * sc); }
        }
        if (BOTH(3)) GRID_BAR();
    }
    if (IN(4)) { RPT(4, ProbDft1 P; P.init(cx); pg8::gemm_phase(lds, P);) if (BOTH(4)) GRID_BAR(); }
    if (IN(5)) { RPT(5, { ProbDft2 P; P.init(cx, 0); pg8::gemm_phase(lds, P); } { ProbDft2 P; P.init(cx, 1); pg8::gemm_phase(lds, P); }) if (BOTH(5)) GRID_BAR(); }
    if (IN(6)) { RPT(6, ProbPlain P; P.init(cx, ws + WS_BOUT, ws + WS_WB, ws + WS_PB, D, DB); pg8::gemm_phase(lds, P);) if (BOTH(6)) GRID_BAR(); }
    if (IN(7)) { RPT(7, ProbMerge P; P.init(cx); pg8::gemm_phase(lds, P);) if (BOTH(7)) GRID_BAR(); }
    if (IN(8)) { RPT(8, ProbOut P; P.init(cx); pg8::gemm_phase(lds, P);) if (BOTH(8)) GRID_BAR(); }
    if (IN(9)) { for (int m = gw; m < TOK; m += NGW) rms_row<false>(args.out + (size_t)m * D, args.in[10], args.out + (size_t)m * D, lane); }
#undef IN
#undef BOTH
#undef GRID_BAR
}

extern "C" void kernel_launch(void* const* d_in, const int* in_sizes, int n_in, void* d_out, int out_size, void* d_ws, size_t ws_size, hipStream_t stream) {
    static int grid = 0;
    if (grid == 0) {
        if (n_in != 11 || ws_size < WS_END) { fprintf(stderr, "kernel_launch: need 11 inputs and >= %zu bytes of workspace (got %d, %zu)\n", (size_t)WS_END, n_in, ws_size); grid = -1; return; }
        int dev = 0, cus = 0;
        if (hipGetDevice(&dev) != hipSuccess || hipDeviceGetAttribute(&cus, hipDeviceAttributeMultiprocessorCount, dev) != hipSuccess) { grid = -1; return; }
        if (hipFuncSetAttribute((const void*)fwd_kernel, hipFuncAttributeMaxDynamicSharedMemorySize, LDS_BYTES) != hipSuccess) { fprintf(stderr, "kernel_launch: hipFuncSetAttribute failed\n"); grid = -1; return; }
        int per_cu = 0;
        if (hipOccupancyMaxActiveBlocksPerMultiprocessor(&per_cu, (const void*)fwd_kernel, NWAVES * 64, LDS_BYTES) != hipSuccess || per_cu < 1) fprintf(stderr, "kernel_launch: occupancy query reports %d\n", per_cu);
        (void)hipGetLastError();
        grid = cus;
    }
    if (grid < 0) return;
    (void)hipMemsetAsync((char*)d_ws + WS_CTL, 0, CTL_ZERO_BYTES, stream);
    Args a{};
    for (int i = 0; i < 11; ++i) a.in[i] = (const float*)d_in[i];
    a.out = (float*)d_out; a.ws = (unsigned char*)d_ws;
    if (MK_N_LAUNCHES == 1) { a.ph_lo = 0; a.ph_hi = N_PHASES; hipLaunchKernelGGL(fwd_kernel, dim3(grid), dim3(NWAVES * 64), LDS_BYTES, stream, a); }
    else for (int li = 0; li < N_PHASES; ++li) { a.ph_lo = li; a.ph_hi = li + 1; hipLaunchKernelGGL(fwd_kernel, dim3(grid), dim3(NWAVES * 64), LDS_BYTES, stream, a); }
}
```

```cpp
#include <hip/hip_runtime.h>
#include <cstdio>
#include <cstdint>

#define LAS __attribute__((address_space(3)))
#define GAS __attribute__((address_space(1)))
typedef unsigned short bf16_t;
typedef short bf16x8 __attribute__((ext_vector_type(8)));
typedef short bf16x4 __attribute__((ext_vector_type(4)));
typedef float f32x2 __attribute__((ext_vector_type(2)));
typedef float f32x4 __attribute__((ext_vector_type(4)));
typedef float f32x16 __attribute__((ext_vector_type(16)));
typedef unsigned u32x2 __attribute__((ext_vector_type(2)));
typedef unsigned u32x4 __attribute__((ext_vector_type(4)));

#ifndef MK_N_LAUNCHES
#define MK_N_LAUNCHES 1
#endif
#ifndef GLA_NAIVE
#define GLA_NAIVE 0
#endif

constexpr int D = 4096, TOK = 32768, NPT = 16384, LP = 8192, LSQ = 2048, NH = 32, DH = 128, DB = 2048, CG = 512;
constexpr int C_U = 20480, C_MA = 24576, C_MB = 28672;
constexpr float EPS = 1e-6f;
constexpr int N_PHASES = 10;
constexpr int REP[10] = {1, 1, 1, 1, 1, 1, 1, 1, 1, 1};

constexpr size_t MiB = 1u << 20;
constexpr size_t WS_CTL = 0, CTL_ZERO_BYTES = 1 * MiB;
constexpr size_t WS_LBF = 1 * MiB, WS_LBB = 1 * MiB + 16384;
constexpr size_t WS_WIN = 2 * MiB, WS_WA = 258 * MiB, WS_WB = 290 * MiB, WS_WO = 306 * MiB, WS_H = 338 * MiB;
constexpr size_t WS_Q = 594 * MiB, WS_KF = 850 * MiB, WS_KB = 1106 * MiB, WS_V = 1362 * MiB, WS_GA = 1618 * MiB;
constexpr size_t WS_DFTC = 1874 * MiB, WS_DFTS2 = 1876 * MiB, WS_BOUT = 1892 * MiB, WS_END = 2020 * MiB;
constexpr size_t WS_PA = WS_Q, WS_U = WS_KF, WS_SGB = WS_KF + 128 * MiB, WS_M = WS_KF, WS_ABT = WS_KB, WS_DFTS8 = WS_V, WS_PB = WS_GA;
constexpr size_t ABT_SAMPLE_OFF = (size_t)2 * 2048 * 16384;
constexpr int CW_TMO = 0, CW_BAR = 4096;

constexpr int RING_BYTES = 131072;
constexpr int LDSCTL_OFF = RING_BYTES, MISC_OFF = LDSCTL_OFF + 320;
constexpr int LDS_BYTES = 147456;
constexpr int NWAVES = 8;

typedef __bf16 bf16x2_t __attribute__((ext_vector_type(2)));
__device__ __forceinline__ unsigned cvt_pk_bf16(float lo, float hi) { f32x2 v = {lo, hi}; bf16x2_t b = __builtin_convertvector(v, bf16x2_t); return __builtin_bit_cast(unsigned, b); }
typedef _Float16 half2_t __attribute__((ext_vector_type(2)));
__device__ __forceinline__ unsigned cvt_pk_f16(float lo, float hi) { f32x2 v = {lo, hi}; half2_t b = __builtin_convertvector(v, half2_t); return __builtin_bit_cast(unsigned, b); }
__device__ __forceinline__ f32x2 unpk_f16(unsigned w) { const half2_t b = __builtin_bit_cast(half2_t, w); return __builtin_convertvector(b, f32x2); }
__device__ __forceinline__ float bf_lo(unsigned w) { return __uint_as_float(w << 16); }
__device__ __forceinline__ float bf_hi(unsigned w) { return __uint_as_float(w & 0xffff0000u); }
__device__ __forceinline__ float fexp(float x) { return __builtin_amdgcn_exp2f(x * 1.44269504089f); }
__device__ __forceinline__ float frcp(float x) { return __builtin_amdgcn_rcpf(x); }
__device__ __forceinline__ float fsig(float x) { return frcp(1.f + fexp(-x)); }
__device__ __forceinline__ float fsilu(float x) { return x * fsig(x); }
__device__ __forceinline__ float flog(float x) { return __builtin_amdgcn_logf(x) * 0.69314718056f; }
__device__ __forceinline__ float wave_sum(float v) {
#pragma unroll
    for (int o = 1; o < 64; o <<= 1) v += __shfl_xor(v, o);
    return v;
}
#define LDS_WAIT() asm volatile("s_waitcnt lgkmcnt(0)" ::: "memory")
#define VM_WAIT() asm volatile("s_waitcnt vmcnt(0)" ::: "memory")

namespace pg8 {
constexpr int BM = 256, BK = 64, HALF = 128, HTB = HALF * BK * 2, STAGE_BYTES = 8 * HTB, NXCD = 8, WGM = 8;
__host__ __device__ __forceinline__ int lds_byte(int r, int c) { const int st = (r >> 4) * 2 + (c >> 5), rr = r & 15, cc = c & 31, ob = rr * 64 + cc * 2; return st * 1024 + (ob ^ (((ob >> 9) & 1) << 5)); }
__host__ __device__ __forceinline__ void stage_rc(int b, int& R, int& C) { const int st = b / 1024, sb = b % 1024, swz = sb ^ (((sb >> 9) & 1) << 5); R = (st >> 1) * 16 + swz / 64; C = (st & 1) * 32 + (swz % 64) / 2; }
__host__ __device__ __forceinline__ int perm32(int rho) { const int n = rho >> 4, i = rho & 15; return 8 * (i >> 2) + 4 * n + (i & 3); }

struct Unit { int pm, pn; };
struct Ptrs { const char* a0; const char* a1; const char* b0; const char* b1; };

struct StaticOrder {
    int nM, nN, nwg, G, c;
    __host__ __device__ void init(int M, int N, int G_, int c_) { nM = M / BM; nN = N / BM; nwg = nM * nN; G = G_; c = c_; }
    __host__ __device__ bool next(int i, Unit& u) const {
        const long L = (long)i * G + c; if (L >= nwg) return false;
        int wgid = (int)L; { const int q = nwg / NXCD, r = nwg % NXCD, xcd = wgid % NXCD, off = wgid / NXCD; wgid = (xcd < r ? xcd * (q + 1) : r * (q + 1) + (xcd - r) * q) + off; }
        const int nig = WGM * nN, gid = wgid / nig, fm = gid * WGM, gsz = (nM - fm) < WGM ? (nM - fm) : WGM;
        u.pm = fm + ((wgid % nig) % gsz); u.pn = (wgid % nig) / gsz; return true;
    }
};

template <class P>
__device__ __forceinline__ void gemm_phase(LAS unsigned char* lds, const P& p) {
    const int tid = threadIdx.x, wid = __builtin_amdgcn_readfirstlane(tid >> 6), lane = tid & 63, wr = wid >> 2, wc = wid & 3, fr = lane & 15, fq = lane >> 4;
    const int nt = p.nt;
    unsigned voffA[2], voffB[2];
#pragma unroll
    for (int i = 0; i < 2; ++i) { int R, C; stage_rc(tid * 16 + i * 8192, R, C); const int Rb = P::PERM ? ((R & ~31) + perm32(R & 31)) : R;
        voffA[i] = (unsigned)(R * p.lda + C) * 2u; voffB[i] = (unsigned)(Rb * p.ldb + C) * 2u; }
    const size_t kstep = (size_t)(BK * 2);
    const unsigned ldsw = (unsigned)wid * 1024u;
    const int aoff = lds_byte(wr * 64 + fr, fq * 8), boff = lds_byte(wc * 32 + fr, fq * 8);
#define PG8_SA(b, h) (((b) * 2 + (h)) * HTB)
#define PG8_SB(b, h) ((4 + (b) * 2 + (h)) * HTB)
#define PG8_STAGE(bufoff, gbase, voff) do { _Pragma("unroll") for (int _i = 0; _i < 2; ++_i) \
        __builtin_amdgcn_global_load_lds((const unsigned*)((const char*)(gbase) + (voff)[_i]), (LAS unsigned*)(lds + (bufoff) + ldsw + _i * 8192), 16, 0, 0); } while (0)
#define PG8_LDA(dst, b, h) do { _Pragma("unroll") for (int m = 0; m < 4; ++m) _Pragma("unroll") for (int k = 0; k < 2; ++k) dst[m][k] = *(const LAS bf16x8*)(lds + PG8_SA(b, h) + aoff + m * 2048 + k * 1024); } while (0)
#define PG8_LDB(dst, b, h) do { _Pragma("unroll") for (int n = 0; n < 2; ++n) _Pragma("unroll") for (int k = 0; k < 2; ++k) dst[n][k] = *(const LAS bf16x8*)(lds + PG8_SB(b, h) + boff + n * 2048 + k * 1024); } while (0)
#define PG8_MMA(ai, bj, At, Bt) do { __builtin_amdgcn_s_setprio(1); _Pragma("unroll") for (int m = 0; m < 4; ++m) _Pragma("unroll") for (int n = 0; n < 2; ++n) _Pragma("unroll") for (int k = 0; k < 2; ++k) \
        acc[ai][bj][m][n] = __builtin_amdgcn_mfma_f32_16x16x32_bf16(Bt[n][k], At[m][k], acc[ai][bj][m][n], 0, 0, 0); __builtin_amdgcn_s_setprio(0); } while (0)
#define PG8_WAIT_V(n) asm volatile("s_waitcnt vmcnt(" #n ")" ::: "memory")
#define PG8_WAIT_L(n) asm volatile("s_waitcnt lgkmcnt(" #n ")" ::: "memory")
#define PG8_BAR __builtin_amdgcn_s_barrier()
#define PG8_SCHED __builtin_amdgcn_sched_barrier(0)
    Unit cur, nxt; int ui = 0;
    if (!p.next(0, cur)) return;
    f32x4 acc[2][2][4][2];
#pragma unroll
    for (int a = 0; a < 2; ++a)
#pragma unroll
        for (int b = 0; b < 2; ++b)
#pragma unroll
            for (int m = 0; m < 4; ++m)
#pragma unroll
                for (int n = 0; n < 2; ++n) acc[a][b][m][n] = (f32x4){0.f, 0.f, 0.f, 0.f};
    bf16x8 At[4][2], B0[2][2], B1[2][2];
    Ptrs cq; p.ptrs(cur, cq);
    PG8_STAGE(PG8_SB(0, 0), cq.b0, voffB); PG8_STAGE(PG8_SB(0, 1), cq.b1, voffB); PG8_STAGE(PG8_SA(0, 0), cq.a0, voffA); PG8_STAGE(PG8_SA(0, 1), cq.a1, voffA);
    if (wr == 1) PG8_BAR;
    PG8_WAIT_V(2); PG8_BAR;
    PG8_STAGE(PG8_SB(1, 0), cq.b0 + kstep, voffB); PG8_STAGE(PG8_SA(1, 0), cq.a0 + kstep, voffA); PG8_STAGE(PG8_SB(1, 1), cq.b1 + kstep, voffB);
    PG8_WAIT_V(6); PG8_BAR;
    for (;;) {
        const bool has_next = p.next(ui + 1, nxt);
        Ptrs nq = cq; if (has_next) p.ptrs(nxt, nq);
        for (int t = 0; t < nt; t += 2) {
            const bool last = (t == nt - 2);
            const size_t o1 = (size_t)(t + 1) * kstep, o2 = (size_t)(t + 2) * kstep;
            const char* a1_1 = cq.a1 + o1;
            const char* a2_0 = last ? nq.a0 : cq.a0 + o2; const char* a2_1 = last ? nq.a1 : cq.a1 + o2;
            const char* b2_0 = last ? nq.b0 : cq.b0 + o2; const char* b2_1 = last ? nq.b1 : cq.b1 + o2;
            PG8_LDB(B0, 0, 0); PG8_LDB(B1, 0, 1); PG8_SCHED; PG8_LDA(At, 0, 0); PG8_STAGE(PG8_SA(1, 1), a1_1, voffA);
            PG8_WAIT_V(8); PG8_WAIT_L(0); PG8_BAR; PG8_MMA(0, 0, At, B0); PG8_MMA(0, 1, At, B1); PG8_BAR; PG8_SCHED;
            PG8_LDA(At, 0, 1); PG8_STAGE(PG8_SB(0, 0), b2_0, voffB); PG8_STAGE(PG8_SB(0, 1), b2_1, voffB); PG8_STAGE(PG8_SA(0, 0), a2_0, voffA);
            PG8_WAIT_V(8); PG8_WAIT_L(0); PG8_BAR; PG8_MMA(1, 0, At, B0); PG8_MMA(1, 1, At, B1); PG8_BAR; PG8_SCHED;
            PG8_LDB(B0, 1, 0); PG8_LDB(B1, 1, 1); PG8_SCHED; PG8_LDA(At, 1, 0); PG8_STAGE(PG8_SA(0, 1), a2_1, voffA);
            PG8_WAIT_V(8); PG8_WAIT_L(0); PG8_BAR; PG8_MMA(0, 0, At, B0); PG8_MMA(0, 1, At, B1); PG8_BAR; PG8_SCHED;
            PG8_LDA(At, 1, 1); PG8_STAGE(PG8_SB(1, 0), b2_0 + kstep, voffB); PG8_STAGE(PG8_SB(1, 1), b2_1 + kstep, voffB); PG8_STAGE(PG8_SA(1, 0), a2_0 + kstep, voffA);
            PG8_WAIT_V(8); PG8_WAIT_L(0); PG8_BAR; PG8_MMA(1, 0, At, B0); PG8_MMA(1, 1, At, B1); PG8_BAR; PG8_SCHED;
        }
        if (wr == 0) PG8_BAR;
        p.epi(acc, cur, wr, wc, fr, fq);
        if (!has_next) break;
#pragma unroll
        for (int a = 0; a < 2; ++a)
#pragma unroll
            for (int b = 0; b < 2; ++b)
#pragma unroll
                for (int m = 0; m < 4; ++m)
#pragma unroll
                    for (int n = 0; n < 2; ++n) acc[a][b][m][n] = (f32x4){0.f, 0.f, 0.f, 0.f};
        cur = nxt; cq = nq; ++ui;
        if (wr == 1) PG8_BAR;
    }
    PG8_WAIT_V(0);
    PG8_BAR;
#undef PG8_SA
#undef PG8_SB
#undef PG8_STAGE
#undef PG8_LDA
#undef PG8_LDB
#undef PG8_MMA
#undef PG8_WAIT_V
#undef PG8_WAIT_L
#undef PG8_BAR
#undef PG8_SCHED
}
}

#define XB_TMO      128
#define XB_XCNT(j)  (256  + 64 * (j))
#define XB_XSUB(j)  (1280 + 64 * (j))
#define XB_XGEN(j)  (2304 + 64 * (j))
#define XB_TOP      3328
#define XB_TOPGEN   3392
#define XCD_BAR_WORDS 3456
#define XB_SPIN_CAP (1u << 18)
__device__ __forceinline__ unsigned xb_ld(unsigned* p)              { return __hip_atomic_load(p, __ATOMIC_RELAXED, __HIP_MEMORY_SCOPE_AGENT); }
__device__ __forceinline__ unsigned xb_add(unsigned* p, unsigned v) { return __hip_atomic_fetch_add(p, v, __ATOMIC_RELAXED, __HIP_MEMORY_SCOPE_AGENT); }
__device__ __forceinline__ unsigned xb_xcc_id() { return (unsigned)__builtin_amdgcn_s_getreg((3 << 11) | 20) & 0xFu; }
#define XB_SPIN(cond, bar) do { unsigned _sp = 0; while (cond) { __builtin_amdgcn_s_sleep(1); \
    if ((++_sp & 255u) == 0u) { if (xb_ld(&(bar)[XB_TMO])) break; if (_sp > XB_SPIN_CAP) { atomicAdd(&(bar)[XB_TMO], 1u); break; } } } } while (0)
struct XcdBarrier { unsigned* bar; unsigned x; volatile LAS unsigned* st; };
__device__ __forceinline__ XcdBarrier xcd_barrier_post(unsigned* bar, volatile LAS unsigned* st) {
    XcdBarrier b; b.bar = bar; b.x = xb_xcc_id(); b.st = st;
    if (threadIdx.x == 0) (void)xb_add(&bar[XB_XCNT(b.x)], 1u);
    return b;
}
__device__ __forceinline__ void xcd_barrier_complete(unsigned* bar, unsigned x, unsigned& nloc, unsigned& nx) {
    const unsigned G = gridDim.x * gridDim.y * gridDim.z;
    unsigned sum, cnt, mine, sp = 0u;
    for (;;) {
        sum = 0u; cnt = 0u; mine = 0u;
#pragma unroll
        for (unsigned j = 0; j < 16; ++j) { const unsigned c = xb_ld(&bar[XB_XCNT(j)]); sum += c; cnt += (c > 0u) ? 1u : 0u; mine = (j == x) ? c : mine; }
        if (sum == G) break;
        __builtin_amdgcn_s_sleep(1);
        if ((++sp & 255u) == 0u) { if (xb_ld(&bar[XB_TMO])) break; if (sp > XB_SPIN_CAP) { atomicAdd(&bar[XB_TMO], 1u); break; } }
    }
    nloc = mine > 0u ? mine : 1u; nx = cnt > 0u ? cnt : 1u;
}
__device__ __forceinline__ void xcd_barrier(const XcdBarrier& b) {
    asm volatile("s_waitcnt vmcnt(0)" ::: "memory");
    __syncthreads();
    if (threadIdx.x == 0) {
        unsigned* bar = b.bar;
        __builtin_amdgcn_s_waitcnt(0);
        unsigned nloc = b.st[0], nx = b.st[1];
        if (nloc == 0u) { xcd_barrier_complete(bar, b.x, nloc, nx); b.st[0] = nloc; b.st[1] = nx; }
        const unsigned old = xb_add(&bar[XB_XSUB(b.x)], 1u);
        const unsigned gen = old / nloc;
        if (old + 1u == (gen + 1u) * nloc) {
            __builtin_amdgcn_fence(__ATOMIC_RELEASE, "agent");
            asm volatile("s_waitcnt vmcnt(0)" ::: "memory");
            const unsigned og = xb_add(&bar[XB_TOP], 1u);
            const unsigned tg = og / nx;
            if (og + 1u == (tg + 1u) * nx) xb_add(&bar[XB_TOPGEN], 1u);
            else XB_SPIN(xb_ld(&bar[XB_TOPGEN]) == tg, bar);
            __builtin_amdgcn_fence(__ATOMIC_ACQUIRE, "agent");
            xb_add(&bar[XB_XGEN(b.x)], 1u);
            asm volatile("s_waitcnt vmcnt(0)" ::: "memory");
        } else {
            XB_SPIN(xb_ld(&bar[XB_XGEN(b.x)]) == gen, bar);
            __builtin_amdgcn_fence(__ATOMIC_ACQUIRE, "agent");
            asm volatile("s_waitcnt vmcnt(0)" ::: "memory");
        }
    }
    __syncthreads();
}

struct Ctx { unsigned char* ws; const float* xp; const float* xs; float* out; int G, c; };

template <bool F16 = false, class F> __device__ __forceinline__ void epi_store_bf16(const f32x4 (&acc)[2][2][4][2], bf16_t* tile  , size_t ldc, const F& f) {
#pragma unroll
    for (int ai = 0; ai < 2; ++ai)
#pragma unroll
        for (int m = 0; m < 4; ++m) { bf16_t* rowp = tile + (size_t)(ai * 128 + m * 16) * ldc;
#pragma unroll
            for (int bj = 0; bj < 2; ++bj) { f32x4 v0 = acc[ai][bj][m][0], v1 = acc[ai][bj][m][1];
                f(v0, v1, bj, ai * 128 + m * 16);
                u32x4 w;
                if (F16) { w.x = cvt_pk_f16(v0[0], v0[1]); w.y = cvt_pk_f16(v0[2], v0[3]); w.z = cvt_pk_f16(v1[0], v1[1]); w.w = cvt_pk_f16(v1[2], v1[3]); }
                else { w.x = cvt_pk_bf16(v0[0], v0[1]); w.y = cvt_pk_bf16(v0[2], v0[3]); w.z = cvt_pk_bf16(v1[0], v1[1]); w.w = cvt_pk_bf16(v1[2], v1[3]); }
                *(u32x4*)(rowp + bj * 128) = w; } }
}
struct FIdent { __device__ __forceinline__ void operator()(f32x4&, f32x4&, int, int) const {} };
struct FSilu { float s; __device__ __forceinline__ void operator()(f32x4& a, f32x4& b, int, int) const {
#pragma unroll
    for (int e = 0; e < 4; ++e) { a[e] = fsilu(a[e]) * s; b[e] = fsilu(b[e]) * s; } } };
struct FLogF { f32x4 lb[2][2]; __device__ __forceinline__ void operator()(f32x4& a, f32x4& b, int bj, int) const {
#pragma unroll
    for (int e = 0; e < 4; ++e) { const float l0 = lb[bj][0][e], l1 = lb[bj][1][e];
        a[e] = l0 + (1.f - l0) * fsig(a[e]); b[e] = l1 + (1.f - l1) * fsig(b[e]); } } };

struct ProbG1a {
    static constexpr bool PERM = true;
    pg8::StaticOrder S; int lda, ldb, nt; unsigned char* ws;
    __device__ __forceinline__ void init(const Ctx& c) { S.init(TOK, 20480, c.G, c.c); lda = D; ldb = D; nt = D / 64; ws = c.ws; }
    __device__ __forceinline__ bool next(int i, pg8::Unit& u) const { return S.next(i, u); }
    __device__ __forceinline__ void ptrs(const pg8::Unit& u, pg8::Ptrs& q) const {
        q.a0 = (const char*)(ws + WS_H) + (size_t)u.pm * 256 * D * 2; q.a1 = q.a0 + (size_t)128 * D * 2;
        q.b0 = (const char*)(ws + WS_WIN) + (size_t)u.pn * 256 * D * 2; q.b1 = q.b0 + (size_t)128 * D * 2; }
    __device__ __forceinline__ void epi(const f32x4 (&acc)[2][2][4][2], const pg8::Unit& u, int wr, int wc, int fr, int fq) const {
        const int seg = u.pn >> 4, colt = (u.pn & 15) * 256 + wc * 32 + 8 * fq, row0 = u.pm * 256 + wr * 64 + fr;
        bf16_t* tile = (bf16_t*)(ws + WS_Q + (size_t)seg * 256 * MiB) + (size_t)row0 * D + colt;
        if (seg == 0) { FSilu f{0.08838834764831845f}; epi_store_bf16(acc, tile, D, f); }
        else if (seg == 1 || seg == 2) { const float* lb = (const float*)(ws + (seg == 1 ? WS_LBF : WS_LBB)) + colt; FLogF f;
#pragma unroll
            for (int bj = 0; bj < 2; ++bj)
#pragma unroll
                for (int n = 0; n < 2; ++n) f.lb[bj][n] = *(const f32x4*)(lb + bj * 128 + 4 * n);
            epi_store_bf16<true>(acc, tile, D, f); }
        else if (seg == 3) { FIdent f; epi_store_bf16(acc, tile, D, f); }
        else { FSilu f{1.f}; epi_store_bf16(acc, tile, D, f); }
    }
};
struct ProbPlain {
    static constexpr bool PERM = true;
    pg8::StaticOrder S; int lda, ldb, nt; const char* A; const char* B; bf16_t* C; int ldc;
    __device__ __forceinline__ void init(const Ctx& c, const void* A_, const void* B_, void* C_, int N, int K) { S.init(TOK, N, c.G, c.c); lda = K; ldb = K; nt = K / 64; A = (const char*)A_; B = (const char*)B_; C = (bf16_t*)C_; ldc = N; }
    __device__ __forceinline__ bool next(int i, pg8::Unit& u) const { return S.next(i, u); }
    __device__ __forceinline__ void ptrs(const pg8::Unit& u, pg8::Ptrs& q) const {
        q.a0 = A + (size_t)u.pm * 256 * lda * 2; q.a1 = q.a0 + (size_t)128 * lda * 2; q.b0 = B + (size_t)u.pn * 256 * ldb * 2; q.b1 = q.b0 + (size_t)128 * ldb * 2; }
    __device__ __forceinline__ void epi(const f32x4 (&acc)[2][2][4][2], const pg8::Unit& u, int wr, int wc, int fr, int fq) const {
        bf16_t* tile = C + (size_t)(u.pm * 256 + wr * 64 + fr) * ldc + u.pn * 256 + wc * 32 + 8 * fq; FIdent f; epi_store_bf16(acc, tile, ldc, f); }
};
struct ProbG1b {
    static constexpr bool PERM = true;
    pg8::StaticOrder S; int lda, ldb, nt; unsigned char* ws;
    __device__ __forceinline__ void init(const Ctx& c) { S.init(TOK, 4096, c.G, c.c); lda = D; ldb = D; nt = D / 64; ws = c.ws; }
    __device__ __forceinline__ bool next(int i, pg8::Unit& u) const { return S.next(i, u); }
    __device__ __forceinline__ void ptrs(const pg8::Unit& u, pg8::Ptrs& q) const {
        q.a0 = (const char*)(ws + WS_H) + (size_t)u.pm * 256 * D * 2; q.a1 = q.a0 + (size_t)128 * D * 2;
        q.b0 = (const char*)(ws + WS_WIN) + (size_t)(C_U + u.pn * 256) * D * 2; q.b1 = q.b0 + (size_t)128 * D * 2; }
    __device__ __forceinline__ void epi(const f32x4 (&acc)[2][2][4][2], const pg8::Unit& u, int wr, int wc, int fr, int fq) const {
        const int seg = u.pn >> 3, colt = (u.pn & 7) * 256 + wc * 32 + 8 * fq, row0 = u.pm * 256 + wr * 64 + fr;
        bf16_t* tile = (bf16_t*)(ws + (seg ? WS_SGB : WS_U)) + (size_t)row0 * DB + colt;
        if (seg == 0) { FIdent f; epi_store_bf16(acc, tile, DB, f); } else { FSilu f{1.f}; epi_store_bf16(acc, tile, DB, f); }
    }
};
struct ProbDft1 {
    static constexpr bool PERM = true;
    pg8::StaticOrder S; int lda, ldb, nt; unsigned char* ws;
    __device__ __forceinline__ void init(const Ctx& c) { S.init(4096, TOK, c.G, c.c); lda = CG; ldb = DB; nt = CG / 64; ws = c.ws; }
    __device__ __forceinline__ bool next(int i, pg8::Unit& u) const { return S.next(i, u); }
    __device__ __forceinline__ void ptrs(const pg8::Unit& u, pg8::Ptrs& q) const {
        const int g = u.pm >> 2, pmr = u.pm & 3;
        q.a0 = (const char*)(ws + WS_DFTC) + (size_t)pmr * 256 * CG * 2; q.a1 = q.a0 + (size_t)128 * CG * 2;
        q.b0 = (const char*)(ws + WS_U) + ((size_t)u.pn * 256 * DB + (size_t)g * CG) * 2; q.b1 = q.b0 + (size_t)128 * DB * 2; }
    __device__ __forceinline__ void epi(const f32x4 (&acc)[2][2][4][2], const pg8::Unit& u, int wr, int wc, int fr, int fq) const {
        const int g = u.pm >> 2, pmr = u.pm & 3, part = pmr >> 1, j0 = (pmr & 1) * 256 + wr * 64 + fr;
        const int tt = u.pn; size_t base; int L, l0;
        if (tt < 64) { L = LP; base = (size_t)(tt >> 5) * 2048 * (2 * LP); l0 = (tt & 31) * 256; }
        else { const int ts = tt - 64; L = LSQ; base = ABT_SAMPLE_OFF + (size_t)(ts >> 3) * 2048 * (2 * LSQ); l0 = (ts & 7) * 256; }
        bf16_t* tile = (bf16_t*)(ws + WS_ABT) + base + (size_t)(g * CG + j0) * (2 * L) + (size_t)part * L + l0 + wc * 32 + 8 * fq;
        FIdent f; epi_store_bf16(acc, tile, (size_t)2 * L, f);
    }
};
struct FMulG { const bf16_t* g; __device__ __forceinline__ void operator()(f32x4& a, f32x4& b, int bj, int roff) const {
    const u32x4 w = *(const u32x4*)(g + (size_t)roff * DB + bj * 128);
    a[0] *= bf_lo(w.x); a[1] *= bf_hi(w.x); a[2] *= bf_lo(w.y); a[3] *= bf_hi(w.y); b[0] *= bf_lo(w.z); b[1] *= bf_hi(w.z); b[2] *= bf_lo(w.w); b[3] *= bf_hi(w.w); } };
struct ProbDft2 {
    static constexpr bool PERM = true;
    pg8::StaticOrder S; int lda, ldb, nt; unsigned char* ws; int L, lshift; size_t abt_off, dfts_off; int tok0;
    __device__ __forceinline__ void init(const Ctx& c, int sample) { S.init(16384, DB, c.G, c.c); ws = c.ws;
        if (!sample) { L = LP; lshift = 5; abt_off = 0; dfts_off = WS_DFTS8; tok0 = 0; } else { L = LSQ; lshift = 3; abt_off = ABT_SAMPLE_OFF; dfts_off = WS_DFTS2; tok0 = NPT; }
        lda = 2 * L; ldb = 2 * L; nt = 2 * L / 64; }
    __device__ __forceinline__ bool next(int i, pg8::Unit& u) const { return S.next(i, u); }
    __device__ __forceinline__ void ptrs(const pg8::Unit& u, pg8::Ptrs& q) const {
        const int b = u.pm >> lshift, pml = u.pm & ((1 << lshift) - 1);
        q.a0 = (const char*)(ws + dfts_off) + (size_t)pml * 256 * (2 * L) * 2; q.a1 = q.a0 + (size_t)128 * (2 * L) * 2;
        q.b0 = (const char*)(ws + WS_ABT) + (abt_off + (size_t)b * 2048 * (2 * L) + (size_t)u.pn * 256 * (2 * L)) * 2; q.b1 = q.b0 + (size_t)128 * (2 * L) * 2; }
    __device__ __forceinline__ void epi(const f32x4 (&acc)[2][2][4][2], const pg8::Unit& u, int wr, int wc, int fr, int fq) const {
        const size_t off = (size_t)(tok0 + u.pm * 256 + wr * 64 + fr) * DB + u.pn * 256 + wc * 32 + 8 * fq;
        FMulG f{(const bf16_t*)(ws + WS_SGB) + off}; epi_store_bf16(acc, (bf16_t*)(ws + WS_BOUT) + off, DB, f);
    }
};
struct ProbMerge {
    static constexpr bool PERM = true;
    pg8::StaticOrder S; int lda, ldb, nt; unsigned char* ws;
    __device__ __forceinline__ void init(const Ctx& c) { S.init(TOK, 8192, c.G, c.c); lda = D; ldb = D; nt = D / 64; ws = c.ws; }
    __device__ __forceinline__ bool next(int i, pg8::Unit& u) const { return S.next(i, u); }
    __device__ __forceinline__ void ptrs(const pg8::Unit& u, pg8::Ptrs& q) const {
        q.a0 = (const char*)(ws + WS_H) + (size_t)u.pm * 256 * D * 2; q.a1 = q.a0 + (size_t)128 * D * 2;
        q.b0 = (const char*)(ws + WS_WIN) + (size_t)(C_MA + u.pn * 128) * D * 2; q.b1 = (const char*)(ws + WS_WIN) + (size_t)(C_MB + u.pn * 128) * D * 2; }
    __device__ __forceinline__ void epi(const f32x4 (&acc)[2][2][4][2], const pg8::Unit& u, int wr, int wc, int fr, int fq) const {
        const size_t off0 = (size_t)(u.pm * 256 + wr * 64 + fr) * D + u.pn * 128 + wc * 32 + 8 * fq;
        const bf16_t* pa = (const bf16_t*)(ws + WS_PA) + off0; const bf16_t* pb = (const bf16_t*)(ws + WS_PB) + off0; bf16_t* mo = (bf16_t*)(ws + WS_M) + off0;
#pragma unroll
        for (int ai = 0; ai < 2; ++ai)
#pragma unroll
            for (int m = 0; m < 4; ++m) { const size_t ro = (size_t)(ai * 128 + m * 16) * D;
                const u32x4 wa = *(const u32x4*)(pa + ro), wb = *(const u32x4*)(pb + ro);
                const f32x4 a0 = acc[ai][0][m][0], a1 = acc[ai][0][m][1], b0 = acc[ai][1][m][0], b1 = acc[ai][1][m][1];
                float r[8];
                r[0] = fsig(a0[0]) * bf_lo(wa.x) + fsig(b0[0]) * bf_lo(wb.x); r[1] = fsig(a0[1]) * bf_hi(wa.x) + fsig(b0[1]) * bf_hi(wb.x);
                r[2] = fsig(a0[2]) * bf_lo(wa.y) + fsig(b0[2]) * bf_lo(wb.y); r[3] = fsig(a0[3]) * bf_hi(wa.y) + fsig(b0[3]) * bf_hi(wb.y);
                r[4] = fsig(a1[0]) * bf_lo(wa.z) + fsig(b1[0]) * bf_lo(wb.z); r[5] = fsig(a1[1]) * bf_hi(wa.z) + fsig(b1[1]) * bf_hi(wb.z);
                r[6] = fsig(a1[2]) * bf_lo(wa.w) + fsig(b1[2]) * bf_lo(wb.w); r[7] = fsig(a1[3]) * bf_hi(wa.w) + fsig(b1[3]) * bf_hi(wb.w);
                u32x4 w; w.x = cvt_pk_bf16(r[0], r[1]); w.y = cvt_pk_bf16(r[2], r[3]); w.z = cvt_pk_bf16(r[4], r[5]); w.w = cvt_pk_bf16(r[6], r[7]);
                *(u32x4*)(mo + ro) = w; }
    }
};
struct ProbOut {
    static constexpr bool PERM = false;
    pg8::StaticOrder S; int lda, ldb, nt; unsigned char* ws; const float* xp; const float* xs; float* out;
    __device__ __forceinline__ void init(const Ctx& c) { S.init(TOK, D, c.G, c.c); lda = D; ldb = D; nt = D / 64; ws = c.ws; xp = c.xp; xs = c.xs; out = c.out; }
    __device__ __forceinline__ bool next(int i, pg8::Unit& u) const { return S.next(i, u); }
    __device__ __forceinline__ void ptrs(const pg8::Unit& u, pg8::Ptrs& q) const {
        q.a0 = (const char*)(ws + WS_M) + (size_t)u.pm * 256 * D * 2; q.a1 = q.a0 + (size_t)128 * D * 2;
        q.b0 = (const char*)(ws + WS_WO) + (size_t)u.pn * 256 * D * 2; q.b1 = q.b0 + (size_t)128 * D * 2; }
    __device__ __forceinline__ void epi(const f32x4 (&acc)[2][2][4][2], const pg8::Unit& u, int wr, int wc, int fr, int fq) const {
        const int row0 = u.pm * 256 + wr * 64 + fr, col0 = u.pn * 256 + wc * 32 + 4 * fq;
        const float* xb = (u.pm < 64) ? xp + (size_t)row0 * D : xs + (size_t)(row0 - NPT) * D;
        float* ob = out + (size_t)row0 * D;
#pragma unroll
        for (int ai = 0; ai < 2; ++ai)
#pragma unroll
            for (int m = 0; m < 4; ++m) { const size_t ro = (size_t)(ai * 128 + m * 16) * D + col0;
#pragma unroll
                for (int bj = 0; bj < 2; ++bj)
#pragma unroll
                    for (int n = 0; n < 2; ++n) { const f32x4 xv = *(const f32x4*)(xb + ro + bj * 128 + n * 16); *(f32x4*)(ob + ro + bj * 128 + n * 16) = acc[ai][bj][m][n] + xv; } }
    }
};

__device__ __forceinline__ unsigned f2bf(float f) { unsigned u = __builtin_bit_cast(unsigned, f); return (u + 0x7fffu + ((u >> 16) & 1u)) >> 16; }
__device__ __forceinline__ unsigned pk2(float lo, float hi) { return f2bf(lo) | (f2bf(hi) << 16); }
__device__ __forceinline__ void p0_transpose_item(const float* W, int K, int N, bf16_t* WT, LAS float* scr, int item, int lane) {
    const int nblk = N / 32, kb = item / nblk, nb = item % nblk, k0 = 64 * kb, n0 = 32 * nb;
#pragma unroll 8
    for (int i = 0; i < 32; ++i) { const int kk = 2 * i + (lane >> 5); scr[kk * 33 + (lane & 31)] = W[(size_t)(k0 + kk) * N + n0 + (lane & 31)]; }
    LDS_WAIT(); asm volatile("" ::: "memory");
    const int c = lane & 7;
#pragma unroll
    for (int j = 0; j < 4; ++j) { const int n = (lane >> 3) + 8 * j; const LAS float* s = scr + (8 * c) * 33 + n;
        u32x4 o; o.x = pk2(s[0 * 33], s[1 * 33]); o.y = pk2(s[2 * 33], s[3 * 33]); o.z = pk2(s[4 * 33], s[5 * 33]); o.w = pk2(s[6 * 33], s[7 * 33]);
        *(u32x4*)(WT + (size_t)(n0 + n) * K + k0 + 8 * c) = o; }
    LDS_WAIT(); asm volatile("" ::: "memory");
}
template <bool OUT_BF16> __device__ __forceinline__ void rms_row(const float* xrow, const float* g, void* orow, int lane) {
    const f32x4* xr = (const f32x4*)xrow + lane;
    f32x4 v[16]; float s = 0.f;
#pragma unroll
    for (int j = 0; j < 16; ++j) { v[j] = xr[64 * j]; s += (v[j].x * v[j].x + v[j].y * v[j].y) + (v[j].z * v[j].z + v[j].w * v[j].w); }
    const float rstd = 1.0f / sqrtf(wave_sum(s) * (1.f / D) + EPS);
    const f32x4* gr = (const f32x4*)g + lane;
#pragma unroll
    for (int j = 0; j < 16; ++j) { const f32x4 gv = gr[64 * j]; const f32x4 y = v[j] * rstd * gv;
        if (OUT_BF16) { u32x2 w; w.x = cvt_pk_bf16(y.x, y.y); w.y = cvt_pk_bf16(y.z, y.w); ((u32x2*)orow)[lane + 64 * j] = w; }
        else ((f32x4*)orow)[lane + 64 * j] = y; }
}

struct Args { const float* in[11]; float* out; unsigned char* ws; int ph_lo, ph_hi; };

__device__ __forceinline__ void gla_pair_info(int p, int& tok0, int& L, int& h) { h = p & 31; if (p < 64) { tok0 = (p >> 5) * LP; L = LP; } else { tok0 = NPT + ((p - 64) >> 5) * LSQ; L = LSQ; } }

#if GLA_NAIVE
__device__ __forceinline__ void gla_pair_naive(LAS unsigned char* lds, unsigned char* ws, const float* ghead, int p) {
    const int tid = threadIdx.x, lane = tid & 63, wave = tid >> 6;
    int tok0, L, h; gla_pair_info(p, tok0, L, h);
    const bf16_t* Q = (const bf16_t*)(ws + WS_Q); bf16_t* KF = (bf16_t*)(ws + WS_KF); const bf16_t* KB = (const bf16_t*)(ws + WS_KB);
    const bf16_t* V = (const bf16_t*)(ws + WS_V); bf16_t* GA = (bf16_t*)(ws + WS_GA);
    LAS float* Lq = (LAS float*)lds; LAS float* Lf = Lq + 16 * 128; LAS float* Lk = Lf + 16 * 128; LAS float* Lv = Lk + 16 * 128; LAS float* Lo = Lv + 16 * 128;
    const int v = tid & 127, kq = tid >> 7;
    for (int pass = 0; pass < 2; ++pass) {
        float S[32];
#pragma unroll
        for (int i = 0; i < 32; ++i) S[i] = 0.f;
        const bf16_t* F = pass ? KB : (const bf16_t*)KF;
        for (int blk = 0; blk < L / 16; ++blk) {
            { const int i = tid >> 5, c4 = (tid & 31) * 4; const int tau = blk * 16 + i; const int t = tok0 + (pass ? (L - 1 - tau) : tau);
              const size_t off = (size_t)t * D + h * DH + c4;
              const u32x2 wq = *(const u32x2*)(Q + off), wf = *(const u32x2*)(F + off), wv = *(const u32x2*)(V + off);
              const float lf0 = bf_lo(wf.x), lf1 = bf_hi(wf.x), lf2 = bf_lo(wf.y), lf3 = bf_hi(wf.y);
              const float f0 = fexp(lf0), f1 = fexp(lf1), f2 = fexp(lf2), f3 = fexp(lf3);
              *(LAS f32x4*)(Lq + i * 128 + c4) = (f32x4){bf_lo(wq.x), bf_hi(wq.x), bf_lo(wq.y), bf_hi(wq.y)};
              *(LAS f32x4*)(Lf + i * 128 + c4) = (f32x4){f0, f1, f2, f3};
              *(LAS f32x4*)(Lk + i * 128 + c4) = (f32x4){1.f - f0, 1.f - f1, 1.f - f2, 1.f - f3};
              *(LAS f32x4*)(Lv + i * 128 + c4) = (f32x4){bf_lo(wv.x), bf_hi(wv.x), bf_lo(wv.y), bf_hi(wv.y)}; }
            __syncthreads();
            for (int i = 0; i < 16; ++i) {
                const float vv = Lv[i * 128 + v]; float op = 0.f;
#pragma unroll
                for (int k4 = 0; k4 < 8; ++k4) {
                    const f32x4 f = *(const LAS f32x4*)(Lf + i * 128 + kq * 32 + k4 * 4), kx = *(const LAS f32x4*)(Lk + i * 128 + kq * 32 + k4 * 4), qx = *(const LAS f32x4*)(Lq + i * 128 + kq * 32 + k4 * 4);
#pragma unroll
                    for (int e = 0; e < 4; ++e) { S[k4 * 4 + e] = f[e] * S[k4 * 4 + e] + kx[e] * vv; op += S[k4 * 4 + e] * qx[e]; }
                }
                Lo[(i * 4 + kq) * 128 + v] = op;
            }
            __syncthreads();
#pragma unroll
            for (int j = 0; j < 2; ++j) { const int i = 2 * wave + j; const int tau = blk * 16 + i; const int t = tok0 + (pass ? (L - 1 - tau) : tau);
                const size_t off = (size_t)t * D + h * DH + 2 * lane;
                float o0 = 0.f, o1 = 0.f;
#pragma unroll
                for (int q = 0; q < 4; ++q) { const f32x2 x = *(const LAS f32x2*)(Lo + (i * 4 + q) * 128 + 2 * lane); o0 += x.x; o1 += x.y; }
                if (pass == 0) { *(unsigned*)(KF + off) = cvt_pk_bf16(o0, o1); }
                else { const unsigned wf = *(const unsigned*)(KF + off), wg = *(const unsigned*)(GA + off);
                    o0 += bf_lo(wf); o1 += bf_hi(wf);
                    const float ss = wave_sum(o0 * o0 + o1 * o1); const float rstd = 1.0f / sqrtf(ss * (1.f / DH) + EPS);
                    const f32x2 gh = *(const f32x2*)(ghead + h * DH + 2 * lane);
                    *(unsigned*)(GA + off) = cvt_pk_bf16(o0 * rstd * gh.x * bf_lo(wg), o1 * rstd * gh.y * bf_hi(wg)); }
            }
            __syncthreads();
        }
        VM_WAIT(); __syncthreads(); __builtin_amdgcn_fence(__ATOMIC_ACQUIRE, "agent"); VM_WAIT(); __syncthreads();
    }
}
#endif

constexpr int GL_QH = 0, GL_KT = 17408, GL_KTT = 34816, GL_VT = 53248, GL_ST = 71680, GL_SEG = 106496, GL_DV = 110592, GL_GH = 111104;
#define LBAR() do { asm volatile("s_waitcnt lgkmcnt(0)" ::: "memory"); __builtin_amdgcn_s_barrier(); asm volatile("" ::: "memory"); } while (0)
#define MFMA32(a, b, c) __builtin_amdgcn_mfma_f32_32x32x16_bf16((a), (b), (c), 0, 0, 0)
template <int PASS>
__device__ __forceinline__ void gla_pass(LAS unsigned char* lds, unsigned char* ws, const float* ghead, int tok0, int L, int h) {
    const int tid = threadIdx.x, lane = tid & 63, wave = __builtin_amdgcn_readfirstlane(tid >> 6);
    const int nchunk = L >> 6, tq = wave >> 2, vt = wave & 3, l31 = lane & 31, hh = lane >> 5;
    const size_t colo = (size_t)h * DH + 2 * lane;
    const bf16_t* Q = (const bf16_t*)(ws + WS_Q) + colo; const bf16_t* F = (const bf16_t*)(ws + (PASS ? WS_KB : WS_KF)) + colo; const bf16_t* V = (const bf16_t*)(ws + WS_V) + colo;
    const int er = lane >> 3, ec = (lane & 7) * 16;
    bf16_t* KFe = (bf16_t*)(ws + WS_KF) + (size_t)h * DH + ec; bf16_t* GAe = (bf16_t*)(ws + WS_GA) + (size_t)h * DH + ec;
    if (PASS && tid < 32) *(LAS f32x4*)(lds + GL_GH + tid * 16) = *(const f32x4*)(ghead + h * DH + tid * 4);
    const long stp = PASS ? -1 : 1;
    f32x16 s0, s1;
#pragma unroll
    for (int i = 0; i < 16; ++i) { s0[i] = 0.f; s1[i] = 0.f; }
    for (int i = tid; i < 34816 / 16; i += 512) ((LAS u32x4*)(lds + GL_ST))[i] = (u32x4){0u, 0u, 0u, 0u};
    unsigned cq[8], cf[8], cv[8];
    { const int tau0 = 8 * wave; const long t0 = tok0 + (PASS ? (L - 1 - tau0) : tau0);
#pragma unroll
      for (int i = 0; i < 8; ++i) { const size_t ro = (size_t)(t0 + stp * i) * D; cq[i] = *(const unsigned*)(Q + ro); cf[i] = *(const unsigned*)(F + ro); cv[i] = *(const unsigned*)(V + ro); } }
    for (int c = 0; c < nchunk; ++c) {
        const int tau0 = 64 * c + 8 * wave; const long t0 = tok0 + (PASS ? (L - 1 - tau0) : tau0);
        const int adv = (c + 1 < nchunk) ? 64 : 0;
        unsigned nq[8], nf[8], nv[8];
#pragma unroll
        for (int i = 0; i < 8; ++i) { const size_t ro = (size_t)(t0 + stp * (adv + i)) * D; nq[i] = *(const unsigned*)(Q + ro); nf[i] = *(const unsigned*)(F + ro); nv[i] = *(const unsigned*)(V + ro); }
        const size_t ero = (size_t)(t0 + stp * er) * D;
        u32x4 wof[2], wga[2];
        if (PASS) { wof[0] = *(const u32x4*)(KFe + ero); wof[1] = *(const u32x4*)(KFe + ero + 8); wga[0] = *(const u32x4*)(GAe + ero); wga[1] = *(const u32x4*)(GAe + ero + 8); }
        float f0[8], f1[8], e0[8], e1[8]; { float r0 = 1.f, r1 = 1.f;
#pragma unroll
            for (int i = 0; i < 8; ++i) { const f32x2 fv = unpk_f16(cf[i]); f0[i] = fv.x; f1[i] = fv.y; r0 *= fv.x; r1 *= fv.y; e0[i] = r0; e1[i] = r1; }
            *(LAS f32x2*)(lds + GL_SEG + (wave * 128 + 2 * lane) * 4) = (f32x2){r0, r1}; }
        LBAR();
        { float p0 = 1.f, p1 = 1.f;
#pragma unroll
          for (int w = 0; w < 7; ++w) if (w < wave) { const f32x2 x = *(const LAS f32x2*)(lds + GL_SEG + (w * 128 + 2 * lane) * 4); p0 *= x.x; p1 *= x.y; }
          unsigned kc0[4], kc1[4], vc0[4], vc1[4]; float kp0 = 0.f, kp1 = 0.f;
#pragma unroll
          for (int i = 0; i < 8; ++i) { const float ee0 = e0[i] * p0, ee1 = e1[i] * p1;
              const float q0 = bf_lo(cq[i]) * ee0, q1 = bf_hi(cq[i]) * ee1;
              const float k0 = (1.f - f0[i]) * frcp(ee0), k1 = (1.f - f1[i]) * frcp(ee1);
              *(LAS unsigned*)(lds + GL_QH + (8 * wave + i) * 272 + 4 * lane) = cvt_pk_bf16(q0, q1);
              *(LAS unsigned*)(lds + GL_KT + (8 * wave + i) * 272 + 4 * lane) = cvt_pk_bf16(k0, k1);
              if (i & 1) { kc0[i >> 1] = cvt_pk_bf16(kp0, k0); kc1[i >> 1] = cvt_pk_bf16(kp1, k1); vc0[i >> 1] = (cv[i - 1] & 0xffffu) | (cv[i] << 16); vc1[i >> 1] = (cv[i - 1] >> 16) | (cv[i] & 0xffff0000u); }
              else { kp0 = k0; kp1 = k1; } }
          if (wave == 7) *(LAS f32x2*)(lds + GL_DV + 2 * lane * 4) = (f32x2){e0[7] * p0, e1[7] * p1};
          *(LAS u32x4*)(lds + GL_KTT + (2 * lane) * 144 + 16 * wave) = (u32x4){kc0[0], kc0[1], kc0[2], kc0[3]};
          *(LAS u32x4*)(lds + GL_KTT + (2 * lane + 1) * 144 + 16 * wave) = (u32x4){kc1[0], kc1[1], kc1[2], kc1[3]};
          *(LAS u32x4*)(lds + GL_VT + (2 * lane) * 144 + 16 * wave) = (u32x4){vc0[0], vc0[1], vc0[2], vc0[3]};
          *(LAS u32x4*)(lds + GL_VT + (2 * lane + 1) * 144 + 16 * wave) = (u32x4){vc1[0], vc1[1], vc1[2], vc1[3]}; }
        LBAR();
        f32x16 oacc;
#pragma unroll
        for (int i = 0; i < 16; ++i) oacc[i] = 0.f;
        bf16x8 qf[8];
#pragma unroll
        for (int kh = 0; kh < 2; ++kh) { bf16x8 sb[4];
#pragma unroll
          for (int k4 = 0; k4 < 4; ++k4) { const int ks = 4 * kh + k4; qf[ks] = *(const LAS bf16x8*)(lds + GL_QH + (32 * tq + l31) * 272 + hh * 16 + ks * 32); sb[k4] = *(const LAS bf16x8*)(lds + GL_ST + (32 * vt + l31) * 272 + hh * 16 + ks * 32); }
          __builtin_amdgcn_sched_barrier(0);
#pragma unroll
          for (int k4 = 0; k4 < 4; ++k4) oacc = MFMA32(qf[4 * kh + k4], sb[k4], oacc); }
#pragma unroll
        for (int kh = 0; kh < 2; ++kh) { bf16x8 vb[2], ka0[2], ka1[2];
#pragma unroll
          for (int k2 = 0; k2 < 2; ++k2) { const int ks = 2 * kh + k2; vb[k2] = *(const LAS bf16x8*)(lds + GL_VT + (32 * vt + l31) * 144 + hh * 16 + ks * 32);
              ka0[k2] = *(const LAS bf16x8*)(lds + GL_KTT + (64 * tq + l31) * 144 + hh * 16 + ks * 32); ka1[k2] = *(const LAS bf16x8*)(lds + GL_KTT + (64 * tq + 32 + l31) * 144 + hh * 16 + ks * 32); }
          __builtin_amdgcn_sched_barrier(0);
#pragma unroll
          for (int k2 = 0; k2 < 2; ++k2) { s0 = MFMA32(ka0[k2], vb[k2], s0); s1 = MFMA32(ka1[k2], vb[k2], s1); } }
        for (int st = 0; st <= tq; ++st) {
            f32x16 x;
#pragma unroll
            for (int i = 0; i < 16; ++i) x[i] = 0.f;
            u32x2 blo[2], bhi[2];
#pragma unroll
            for (int kh = 0; kh < 2; ++kh) { bf16x8 ka[4];
#pragma unroll
              for (int k4 = 0; k4 < 4; ++k4) ka[k4] = *(const LAS bf16x8*)(lds + GL_KT + (32 * st + l31) * 272 + hh * 16 + (4 * kh + k4) * 32);
              if (kh == 1) {
#pragma unroll
                  for (int sp = 0; sp < 2; ++sp) { const LAS unsigned char* vp = lds + GL_VT + (32 * vt + l31) * 144 + 64 * st + 32 * sp + 8 * hh; blo[sp] = *(const LAS u32x2*)vp; bhi[sp] = *(const LAS u32x2*)(vp + 16); } }
              __builtin_amdgcn_sched_barrier(0);
#pragma unroll
              for (int k4 = 0; k4 < 4; ++k4) x = MFMA32(ka[k4], qf[4 * kh + k4], x); }
            if (st == tq) {
#pragma unroll
                for (int r = 0; r < 16; ++r) { const int sl = (r & 3) + 8 * (r >> 2) + 4 * hh; x[r] = (sl <= l31) ? x[r] : 0.f; }
            }
#pragma unroll
            for (int sp = 0; sp < 2; ++sp) {
                u32x4 aw; aw.x = cvt_pk_bf16(x[8 * sp + 0], x[8 * sp + 1]); aw.y = cvt_pk_bf16(x[8 * sp + 2], x[8 * sp + 3]); aw.z = cvt_pk_bf16(x[8 * sp + 4], x[8 * sp + 5]); aw.w = cvt_pk_bf16(x[8 * sp + 6], x[8 * sp + 7]);
                const u32x4 bw = (u32x4){blo[sp].x, blo[sp].y, bhi[sp].x, bhi[sp].y};
                oacc = MFMA32(__builtin_bit_cast(bf16x8, aw), __builtin_bit_cast(bf16x8, bw), oacc);
            }
        }
#pragma unroll
        for (int g = 0; g < 4; ++g) { const f32x4 d0 = *(const LAS f32x4*)(lds + GL_DV + (64 * tq + 8 * g + 4 * hh) * 4), d1 = *(const LAS f32x4*)(lds + GL_DV + (64 * tq + 32 + 8 * g + 4 * hh) * 4);
#pragma unroll
            for (int e = 0; e < 4; ++e) { s0[4 * g + e] *= d0[e]; s1[4 * g + e] *= d1[e]; } }
        LBAR();
#pragma unroll
        for (int r = 0; r < 16; ++r) { const int tl = (r & 3) + 8 * (r >> 2) + 4 * hh; *(LAS float*)(lds + ((32 * tq + tl) * 132 + 32 * vt + l31) * 4) = oacc[r]; }
#pragma unroll
        for (int g = 0; g < 4; ++g) {
            *(LAS u32x2*)(lds + GL_ST + (32 * vt + l31) * 272 + (64 * tq + 8 * g + 4 * hh) * 2) = (u32x2){cvt_pk_bf16(s0[4 * g], s0[4 * g + 1]), cvt_pk_bf16(s0[4 * g + 2], s0[4 * g + 3])};
            *(LAS u32x2*)(lds + GL_ST + (32 * vt + l31) * 272 + (64 * tq + 32 + 8 * g + 4 * hh) * 2) = (u32x2){cvt_pk_bf16(s1[4 * g], s1[4 * g + 1]), cvt_pk_bf16(s1[4 * g + 2], s1[4 * g + 3])}; }
        LBAR();
        { f32x4 o4[4];
#pragma unroll
          for (int j = 0; j < 4; ++j) o4[j] = *(const LAS f32x4*)(lds + ((8 * wave + er) * 132 + ec + 4 * j) * 4);
          if (PASS == 0) {
              u32x4 w0, w1; w0.x = cvt_pk_bf16(o4[0].x, o4[0].y); w0.y = cvt_pk_bf16(o4[0].z, o4[0].w); w0.z = cvt_pk_bf16(o4[1].x, o4[1].y); w0.w = cvt_pk_bf16(o4[1].z, o4[1].w);
              w1.x = cvt_pk_bf16(o4[2].x, o4[2].y); w1.y = cvt_pk_bf16(o4[2].z, o4[2].w); w1.z = cvt_pk_bf16(o4[3].x, o4[3].y); w1.w = cvt_pk_bf16(o4[3].z, o4[3].w);
              *(u32x4*)(KFe + ero) = w0; *(u32x4*)(KFe + ero + 8) = w1;
          } else {
              o4[0] += (f32x4){bf_lo(wof[0].x), bf_hi(wof[0].x), bf_lo(wof[0].y), bf_hi(wof[0].y)}; o4[1] += (f32x4){bf_lo(wof[0].z), bf_hi(wof[0].z), bf_lo(wof[0].w), bf_hi(wof[0].w)};
              o4[2] += (f32x4){bf_lo(wof[1].x), bf_hi(wof[1].x), bf_lo(wof[1].y), bf_hi(wof[1].y)}; o4[3] += (f32x4){bf_lo(wof[1].z), bf_hi(wof[1].z), bf_lo(wof[1].w), bf_hi(wof[1].w)};
              float ss = 0.f;
#pragma unroll
              for (int j = 0; j < 4; ++j) ss += (o4[j].x * o4[j].x + o4[j].y * o4[j].y) + (o4[j].z * o4[j].z + o4[j].w * o4[j].w);
              ss += __shfl_xor(ss, 1); ss += __shfl_xor(ss, 2); ss += __shfl_xor(ss, 4);
              const float rstd = 1.0f / sqrtf(ss * (1.f / DH) + EPS);
#pragma unroll
              for (int j = 0; j < 4; ++j) o4[j] = o4[j] * rstd * *(const LAS f32x4*)(lds + GL_GH + (ec + 4 * j) * 4);
              u32x4 w0, w1;
              w0.x = cvt_pk_bf16(o4[0].x * bf_lo(wga[0].x), o4[0].y * bf_hi(wga[0].x)); w0.y = cvt_pk_bf16(o4[0].z * bf_lo(wga[0].y), o4[0].w * bf_hi(wga[0].y));
              w0.z = cvt_pk_bf16(o4[1].x * bf_lo(wga[0].z), o4[1].y * bf_hi(wga[0].z)); w0.w = cvt_pk_bf16(o4[1].z * bf_lo(wga[0].w), o4[1].w * bf_hi(wga[0].w));
              w1.x = cvt_pk_bf16(o4[2].x * bf_lo(wga[1].x), o4[2].y * bf_hi(wga[1].x)); w1.y = cvt_pk_bf16(o4[2].z * bf_lo(wga[1].y), o4[2].w * bf_hi(wga[1].y));
              w1.z = cvt_pk_bf16(o4[3].x * bf_lo(wga[1].z), o4[3].y * bf_hi(wga[1].z)); w1.w = cvt_pk_bf16(o4[3].z * bf_lo(wga[1].w), o4[3].w * bf_hi(wga[1].w));
              *(u32x4*)(GAe + ero) = w0; *(u32x4*)(GAe + ero + 8) = w1;
          } }
#pragma unroll
        for (int i = 0; i < 8; ++i) { asm volatile("" : "+v"(nq[i]), "+v"(nf[i]), "+v"(nv[i])); cq[i] = nq[i]; cf[i] = nf[i]; cv[i] = nv[i]; }
    }
    VM_WAIT(); __syncthreads(); __builtin_amdgcn_fence(__ATOMIC_ACQUIRE, "agent"); VM_WAIT(); __syncthreads();
}
__device__ __forceinline__ void gla_pair_mfma(LAS unsigned char* lds, unsigned char* ws, const float* ghead, int p) {
    int tok0, L, h; gla_pair_info(p, tok0, L, h);
    gla_pass<0>(lds, ws, ghead, tok0, L, h);
    gla_pass<1>(lds, ws, ghead, tok0, L, h);
}

__device__ __forceinline__ void gla_phase(LAS unsigned char* lds, unsigned char* ws, const float* ghead, int vcu, int G) {
#if GLA_NAIVE
#define GLA_PAIR gla_pair_naive
#else
#define GLA_PAIR gla_pair_mfma
#endif
    if (G == 256) { GLA_PAIR(lds, ws, ghead, vcu); if (vcu >= 64 && vcu < 128) GLA_PAIR(lds, ws, ghead, vcu + 192); }
    else { for (int p = vcu; p < 320; p += G) GLA_PAIR(lds, ws, ghead, p); }
}

__device__ __forceinline__ void p0_body(const Args& args, unsigned char* ws, LAS unsigned char* lds, int G, int bx, int tid, int lane, int wave, int gw, int NGW) {
        LAS float* scr = (LAS float*)(lds + wave * 16384);
        const float* w_in = args.in[3]; const float* w_a = args.in[7]; const float* w_b = args.in[8]; const float* w_o = args.in[9];
        constexpr int I_IN = (D / 64) * (32768 / 32), I_A = (D / 64) * (D / 32), I_B = (DB / 64) * (D / 32), I_O = I_A;
        for (int it = gw; it < I_IN + I_A + I_B + I_O; it += NGW) {
            int r = it;
            if (r < I_IN) { p0_transpose_item(w_in, D, 32768, (bf16_t*)(ws + WS_WIN), scr, r, lane); continue; } r -= I_IN;
            if (r < I_A) { p0_transpose_item(w_a, D, D, (bf16_t*)(ws + WS_WA), scr, r, lane); continue; } r -= I_A;
            if (r < I_B) { p0_transpose_item(w_b, DB, D, (bf16_t*)(ws + WS_WB), scr, r, lane); continue; } r -= I_B;
            p0_transpose_item(w_o, D, D, (bf16_t*)(ws + WS_WO), scr, r, lane);
        }
        for (int m = gw; m < TOK; m += NGW) { const float* xr = (m < NPT) ? args.in[0] + (size_t)m * D : args.in[1] + (size_t)(m - NPT) * D;
            rms_row<true>(xr, args.in[2], (bf16_t*)(ws + WS_H) + (size_t)m * D, lane); }
        for (int i = bx * 512 + tid; i < 2 * D; i += G * 512) { const float* lbp = (i < D) ? args.in[4] : args.in[5]; const int c = i & (D - 1);
            const float a0 = lbp[c], a1 = lbp[D + c]; ((float*)(ws + (i < D ? WS_LBF : WS_LBB)))[c] = 1.0f / (1.0f + expf(a1 - a0)); }
        for (int i = bx * 512 + tid; i < 1024 * 512; i += G * 512) { const int r = i >> 9, c = i & 511, j = r & 511, part = r >> 9; const float ph = (float)((j * c) & 511) * (1.f / 512.f);
            const float vv = (part ? __builtin_amdgcn_sinf(ph) : __builtin_amdgcn_cosf(ph)) * 0.04419417382415922f; ((bf16_t*)(ws + WS_DFTC))[i] = (bf16_t)f2bf(vv); }
        }

__global__ void __launch_bounds__(NWAVES * 64, 2) fwd_kernel(Args args) {
    extern __shared__ __attribute__((aligned(16))) unsigned char lds_raw[];
    LAS unsigned char* lds = (LAS unsigned char*)lds_raw;
    volatile LAS unsigned* MISC = (volatile LAS unsigned*)(lds + MISC_OFF);
    const int tid = threadIdx.x, lane = tid & 63, wave = __builtin_amdgcn_readfirstlane(tid >> 6);
    const int G = gridDim.x; const int bx = blockIdx.x; const int vcu = (G % 8 == 0) ? (bx % 8) * (G / 8) + bx / 8 : bx;
    unsigned char* ws = args.ws;
    unsigned* ctl = (unsigned*)(ws + WS_CTL);
    for (int u = tid; u < (LDS_BYTES - LDSCTL_OFF) / 4; u += NWAVES * 64) ((LAS unsigned*)(lds + LDSCTL_OFF))[u] = 0u;
    __syncthreads();
    XcdBarrier bar; bar.bar = ctl + CW_BAR; bar.x = 0; bar.st = nullptr;
    if (MK_N_LAUNCHES == 1) bar = xcd_barrier_post(ctl + CW_BAR, MISC + 8);
    const int lo = args.ph_lo, hi = args.ph_hi;
#define IN(k) (lo <= (k) && (k) < hi)
#define BOTH(k) (IN(k) && IN((k) + 1))
#define RPT(k, ...) do { { __VA_ARGS__ } if constexpr (REP[k] > 1) { __VA_ARGS__ } } while (0);
#define GRID_BAR() do { if (MK_N_LAUNCHES == 1) xcd_barrier(bar); } while (0)
    Ctx cx; cx.ws = ws; cx.xp = args.in[0]; cx.xs = args.in[1]; cx.out = args.out; cx.G = G; cx.c = bx;
    const int gw = vcu * NWAVES + wave, NGW = G * NWAVES;

    if (IN(0)) { RPT(0, p0_body(args, ws, lds, G, bx, tid, lane, wave, gw, NGW);)
        if (BOTH(0)) GRID_BAR();
    }
    if (IN(1)) { RPT(1, ProbG1a P; P.init(cx); pg8::gemm_phase(lds, P);) if (BOTH(1)) GRID_BAR(); }
    if (IN(2)) { gla_phase(lds, ws, args.in[6], vcu, G); if (BOTH(2)) GRID_BAR(); }
    if (IN(3)) { {
        RPT(3, { ProbPlain P; P.init(cx, ws + WS_GA, ws + WS_WA, ws + WS_PA, D, D); pg8::gemm_phase(lds, P); }
        { ProbG1b P; P.init(cx); pg8::gemm_phase(lds, P); })
        for (size_t i = ((size_t)bx * 512 + tid) * 2; i < (size_t)LP * 2 * LP; i += (size_t)G * 1024) { const int lp = (int)(i >> 14), kk = (int)(i & 16383), part = kk >> 13, l = kk & 8191;
            const float p0 = (float)((lp * l) & 8191) * (1.f / 8192.f), p1 = (float)((lp * (l + 1)) & 8191) * (1.f / 8192.f); const float sc = 0.011048543456039806f;
            const float v0 = part ? -__builtin_amdgcn_sinf(p0) : __builtin_amdgcn_cosf(p0), v1 = part ? -__builtin_amdgcn_sinf(p1) : __builtin_amdgcn_cosf(p1);
            *(unsigned*)((bf16_t*)(ws + WS_DFTS8) + i) = cvt_pk_bf16(v0 * sc, v1 * sc); }
        for (size_t i = ((size_t)bx * 512 + tid) * 2; i < (size_t)LSQ * 2 * LSQ; i += (size_t)G * 1024) { const int lp = (int)(i >> 12), kk = (int)(i & 4095), part = kk >> 11, l = kk & 2047;
            const float p0 = (float)((lp * l) & 2047) * (1.f / 2048.f), p1 = (float)((lp * (l + 1)) & 2047) * (1.f / 2048.f); const float sc = 0.022097086912079608f;
            const float v0 = part ? -__builtin_amdgcn_sinf(p0) : __builtin_amdgcn_cosf(p0), v1 = part ? -__builtin_amdgcn_sinf(p1) : __builtin_amdgcn_cosf(p1);
            *(unsigned*)((bf16_t*)(ws + WS_DFTS2) + i) = cvt_pk_bf16(v0 * sc, v1 * sc); }
        }
        if (BOTH(3)) GRID_BAR();
    }
    if (IN(4)) { RPT(4, ProbDft1 P; P.init(cx); pg8::gemm_phase(lds, P);) if (BOTH(4)) GRID_BAR(); }
    if (IN(5)) { RPT(5, { ProbDft2 P; P.init(cx, 0); pg8::gemm_phase(lds, P); } { ProbDft2 P; P.init(cx, 1); pg8::gemm_phase(lds, P); }) if (BOTH(5)) GRID_BAR(); }
    if (IN(6)) { RPT(6, ProbPlain P; P.init(cx, ws + WS_BOUT, ws + WS_WB, ws + WS_PB, D, DB); pg8::gemm_phase(lds, P);) if (BOTH(6)) GRID_BAR(); }
    if (IN(7)) { RPT(7, ProbMerge P; P.init(cx); pg8::gemm_phase(lds, P);) if (BOTH(7)) GRID_BAR(); }
    if (IN(8)) { RPT(8, ProbOut P; P.init(cx); pg8::gemm_phase(lds, P);) if (BOTH(8)) GRID_BAR(); }
    if (IN(9)) { for (int m = gw; m < TOK; m += NGW) rms_row<false>(args.out + (size_t)m * D, args.in[10], args.out + (size_t)m * D, lane); }
#undef IN
#undef BOTH
#undef GRID_BAR
}

extern "C" void kernel_launch(void* const* d_in, const int* in_sizes, int n_in, void* d_out, int out_size, void* d_ws, size_t ws_size, hipStream_t stream) {
    static int grid = 0;
    if (grid == 0) {
        if (n_in != 11 || ws_size < WS_END) { fprintf(stderr, "kernel_launch: need 11 inputs and >= %zu bytes of workspace (got %d, %zu)\n", (size_t)WS_END, n_in, ws_size); grid = -1; return; }
        int dev = 0, cus = 0;
        if (hipGetDevice(&dev) != hipSuccess || hipDeviceGetAttribute(&cus, hipDeviceAttributeMultiprocessorCount, dev) != hipSuccess) { grid = -1; return; }
        if (hipFuncSetAttribute((const void*)fwd_kernel, hipFuncAttributeMaxDynamicSharedMemorySize, LDS_BYTES) != hipSuccess) { fprintf(stderr, "kernel_launch: hipFuncSetAttribute failed\n"); grid = -1; return; }
        int per_cu = 0;
        if (hipOccupancyMaxActiveBlocksPerMultiprocessor(&per_cu, (const void*)fwd_kernel, NWAVES * 64, LDS_BYTES) != hipSuccess || per_cu < 1) fprintf(stderr, "kernel_launch: occupancy query reports %d\n", per_cu);
        (void)hipGetLastError();
        grid = cus;
    }
    if (grid < 0) return;
    (void)hipMemsetAsync((char*)d_ws + WS_CTL, 0, CTL_ZERO_BYTES, stream);
    Args a{};
    for (int i = 0; i < 11; ++i) a.in[i] = (const float*)d_in[i];
    a.out = (float*)d_out; a.ws = (unsigned char*)d_ws;
    if (MK_N_LAUNCHES == 1) { a.ph_lo = 0; a.ph_hi = N_PHASES; hipLaunchKernelGGL(fwd_kernel, dim3(grid), dim3(NWAVES * 64), LDS_BYTES, stream, a); }
    else for (int li = 0; li < N_PHASES; ++li) { a.ph_lo = li; a.ph_hi = li + 1; hipLaunchKernelGGL(fwd_kernel, dim3(grid), dim3(NWAVES * 64), LDS_BYTES, stream, a); }
}
```

```cpp
#include <hip/hip_runtime.h>
#include <cstdio>
#include <cstdint>

#define LAS __attribute__((address_space(3)))
#define GAS __attribute__((address_space(1)))
typedef unsigned short bf16_t;
typedef short bf16x8 __attribute__((ext_vector_type(8)));
typedef short bf16x4 __attribute__((ext_vector_type(4)));
typedef float f32x2 __attribute__((ext_vector_type(2)));
typedef float f32x4 __attribute__((ext_vector_type(4)));
typedef float f32x16 __attribute__((ext_vector_type(16)));
typedef unsigned u32x2 __attribute__((ext_vector_type(2)));
typedef unsigned u32x4 __attribute__((ext_vector_type(4)));

#ifndef MK_N_LAUNCHES
#define MK_N_LAUNCHES 1
#endif
#ifndef GLA_NAIVE
#define GLA_NAIVE 0
#endif

constexpr int D = 4096, TOK = 32768, NPT = 16384, LP = 8192, LSQ = 2048, NH = 32, DH = 128, DB = 2048, CG = 512;
constexpr int C_U = 20480, C_MA = 24576, C_MB = 28672;
constexpr float EPS = 1e-6f;
constexpr int N_PHASES = 10;
constexpr int REP[10] = {1, 1, 1, 1, 1, 1, 1, 1, 1, 1};

constexpr size_t MiB = 1u << 20;
constexpr size_t WS_CTL = 0, CTL_ZERO_BYTES = 1 * MiB;
constexpr size_t WS_LBF = 1 * MiB, WS_LBB = 1 * MiB + 16384;
constexpr size_t WS_WIN = 2 * MiB, WS_WA = 258 * MiB, WS_WB = 290 * MiB, WS_WO = 306 * MiB, WS_H = 338 * MiB;
constexpr size_t WS_Q = 594 * MiB, WS_KF = 850 * MiB, WS_KB = 1106 * MiB, WS_V = 1362 * MiB, WS_GA = 1618 * MiB;
constexpr size_t WS_DFTC = 1874 * MiB, WS_DFTS = 1876 * MiB, WS_DFTS_S = 1880 * MiB, WS_BOUT = 1892 * MiB, WS_END = 2020 * MiB;
constexpr size_t WS_PA = WS_Q, WS_SGB = WS_KF + 128 * MiB, WS_M = WS_KF, WS_ABT = WS_KB, WS_TU = WS_V, WS_PB = WS_GA;
constexpr size_t ABT_SEQ_P = (size_t)8 * 2048 * 2 * 1024, ABT_SEQ_S = (size_t)8 * 2048 * 2 * 256;
__device__ __forceinline__ void row_map(int pm, int wr, int fr, int& tokb, int& L8) { int s0, T; if (pm < 64) { s0 = (pm >> 5) * LP; T = pm & 31; L8 = LP / 8; } else { const int ps = pm - 64; s0 = NPT + (ps >> 3) * LSQ; T = ps & 7; L8 = LSQ / 8; } tokb = s0 + 32 * T + 16 * wr + fr; }
constexpr int CW_TMO = 0, CW_BAR = 4096;

constexpr int RING_BYTES = 131072;
constexpr int LDSCTL_OFF = RING_BYTES, MISC_OFF = LDSCTL_OFF + 320;
constexpr int LDS_BYTES = 147456;
constexpr int NWAVES = 8;

typedef __bf16 bf16x2_t __attribute__((ext_vector_type(2)));
__device__ __forceinline__ unsigned cvt_pk_bf16(float lo, float hi) { f32x2 v = {lo, hi}; bf16x2_t b = __builtin_convertvector(v, bf16x2_t); return __builtin_bit_cast(unsigned, b); }
typedef _Float16 half2_t __attribute__((ext_vector_type(2)));
__device__ __forceinline__ unsigned cvt_pk_f16(float lo, float hi) { f32x2 v = {lo, hi}; half2_t b = __builtin_convertvector(v, half2_t); return __builtin_bit_cast(unsigned, b); }
__device__ __forceinline__ f32x2 unpk_f16(unsigned w) { const half2_t b = __builtin_bit_cast(half2_t, w); return __builtin_convertvector(b, f32x2); }
__device__ __forceinline__ float bf_lo(unsigned w) { return __uint_as_float(w << 16); }
__device__ __forceinline__ float bf_hi(unsigned w) { return __uint_as_float(w & 0xffff0000u); }
__device__ __forceinline__ float fexp(float x) { return __builtin_amdgcn_exp2f(x * 1.44269504089f); }
__device__ __forceinline__ float frcp(float x) { return __builtin_amdgcn_rcpf(x); }
__device__ __forceinline__ float fsig(float x) { return frcp(1.f + fexp(-x)); }
__device__ __forceinline__ float fsilu(float x) { return x * fsig(x); }
__device__ __forceinline__ float flog(float x) { return __builtin_amdgcn_logf(x) * 0.69314718056f; }
__device__ __forceinline__ float wave_sum(float v) {
#pragma unroll
    for (int o = 1; o < 64; o <<= 1) v += __shfl_xor(v, o);
    return v;
}
#define LDS_WAIT() asm volatile("s_waitcnt lgkmcnt(0)" ::: "memory")
#define VM_WAIT() asm volatile("s_waitcnt vmcnt(0)" ::: "memory")

namespace pg8 {
constexpr int BM = 256, BK = 64, HALF = 128, HTB = HALF * BK * 2, STAGE_BYTES = 8 * HTB, NXCD = 8, WGM = 8;
__host__ __device__ __forceinline__ int lds_byte(int r, int c) { const int st = (r >> 4) * 2 + (c >> 5), rr = r & 15, cc = c & 31, ob = rr * 64 + cc * 2; return st * 1024 + (ob ^ (((ob >> 9) & 1) << 5)); }
__host__ __device__ __forceinline__ void stage_rc(int b, int& R, int& C) { const int st = b / 1024, sb = b % 1024, swz = sb ^ (((sb >> 9) & 1) << 5); R = (st >> 1) * 16 + swz / 64; C = (st & 1) * 32 + (swz % 64) / 2; }
__host__ __device__ __forceinline__ int perm32(int rho) { const int n = rho >> 4, i = rho & 15; return 8 * (i >> 2) + 4 * n + (i & 3); }

struct Unit { int pm, pn; };
struct Ptrs { const char* a0; const char* a1; const char* b0; const char* b1; };

struct StaticOrder {
    int nM, nN, nwg, G, c;
    __host__ __device__ void init(int M, int N, int G_, int c_) { nM = M / BM; nN = N / BM; nwg = nM * nN; G = G_; c = c_; }
    __host__ __device__ bool next(int i, Unit& u) const {
        const long L = (long)i * G + c; if (L >= nwg) return false;
        int wgid = (int)L; { const int q = nwg / NXCD, r = nwg % NXCD, xcd = wgid % NXCD, off = wgid / NXCD; wgid = (xcd < r ? xcd * (q + 1) : r * (q + 1) + (xcd - r) * q) + off; }
        const int nig = WGM * nN, gid = wgid / nig, fm = gid * WGM, gsz = (nM - fm) < WGM ? (nM - fm) : WGM;
        u.pm = fm + ((wgid % nig) % gsz); u.pn = (wgid % nig) / gsz; return true;
    }
};

template <class P>
__device__ __forceinline__ void gemm_phase(LAS unsigned char* lds, const P& p) {
    const int tid = threadIdx.x, wid = __builtin_amdgcn_readfirstlane(tid >> 6), lane = tid & 63, wr = wid >> 2, wc = wid & 3, fr = lane & 15, fq = lane >> 4;
    const int nt = p.nt;
    unsigned voffA[2], voffB[2];
#pragma unroll
    for (int i = 0; i < 2; ++i) { int R, C; stage_rc(tid * 16 + i * 8192, R, C); const int Rb = P::PERM ? ((R & ~31) + perm32(R & 31)) : R;
        voffA[i] = (unsigned)(R * p.lda + C) * 2u; voffB[i] = (unsigned)(Rb * p.ldb + C) * 2u; }
    const size_t kstep = (size_t)(BK * 2);
    const unsigned ldsw = (unsigned)wid * 1024u;
    const int aoff = lds_byte(wr * 64 + fr, fq * 8), boff = lds_byte(wc * 32 + fr, fq * 8);
#define PG8_SA(b, h) (((b) * 2 + (h)) * HTB)
#define PG8_SB(b, h) ((4 + (b) * 2 + (h)) * HTB)
#define PG8_STAGE(bufoff, gbase, voff) do { _Pragma("unroll") for (int _i = 0; _i < 2; ++_i) \
        __builtin_amdgcn_global_load_lds((const unsigned*)((const char*)(gbase) + (voff)[_i]), (LAS unsigned*)(lds + (bufoff) + ldsw + _i * 8192), 16, 0, 0); } while (0)
#define PG8_LDA(dst, b, h) do { _Pragma("unroll") for (int m = 0; m < 4; ++m) _Pragma("unroll") for (int k = 0; k < 2; ++k) dst[m][k] = *(const LAS bf16x8*)(lds + PG8_SA(b, h) + aoff + m * 2048 + k * 1024); } while (0)
#define PG8_LDB(dst, b, h) do { _Pragma("unroll") for (int n = 0; n < 2; ++n) _Pragma("unroll") for (int k = 0; k < 2; ++k) dst[n][k] = *(const LAS bf16x8*)(lds + PG8_SB(b, h) + boff + n * 2048 + k * 1024); } while (0)
#define PG8_MMA(ai, bj, At, Bt) do { __builtin_amdgcn_s_setprio(1); _Pragma("unroll") for (int m = 0; m < 4; ++m) _Pragma("unroll") for (int n = 0; n < 2; ++n) _Pragma("unroll") for (int k = 0; k < 2; ++k) \
        acc[ai][bj][m][n] = __builtin_amdgcn_mfma_f32_16x16x32_bf16(Bt[n][k], At[m][k], acc[ai][bj][m][n], 0, 0, 0); __builtin_amdgcn_s_setprio(0); } while (0)
#define PG8_WAIT_V(n) asm volatile("s_waitcnt vmcnt(" #n ")" ::: "memory")
#define PG8_WAIT_L(n) asm volatile("s_waitcnt lgkmcnt(" #n ")" ::: "memory")
#define PG8_BAR __builtin_amdgcn_s_barrier()
#define PG8_SCHED __builtin_amdgcn_sched_barrier(0)
    Unit cur, nxt; int ui = 0;
    if (!p.next(0, cur)) return;
    f32x4 acc[2][2][4][2];
#pragma unroll
    for (int a = 0; a < 2; ++a)
#pragma unroll
        for (int b = 0; b < 2; ++b)
#pragma unroll
            for (int m = 0; m < 4; ++m)
#pragma unroll
                for (int n = 0; n < 2; ++n) acc[a][b][m][n] = (f32x4){0.f, 0.f, 0.f, 0.f};
    bf16x8 At[4][2], B0[2][2], B1[2][2];
    Ptrs cq; p.ptrs(cur, cq);
    PG8_STAGE(PG8_SB(0, 0), cq.b0, voffB); PG8_STAGE(PG8_SB(0, 1), cq.b1, voffB); PG8_STAGE(PG8_SA(0, 0), cq.a0, voffA); PG8_STAGE(PG8_SA(0, 1), cq.a1, voffA);
    if (wr == 1) PG8_BAR;
    PG8_WAIT_V(2); PG8_BAR;
    PG8_STAGE(PG8_SB(1, 0), cq.b0 + kstep, voffB); PG8_STAGE(PG8_SA(1, 0), cq.a0 + kstep, voffA); PG8_STAGE(PG8_SB(1, 1), cq.b1 + kstep, voffB);
    PG8_WAIT_V(6); PG8_BAR;
    for (;;) {
        const bool has_next = p.next(ui + 1, nxt);
        Ptrs nq = cq; if (has_next) p.ptrs(nxt, nq);
        for (int t = 0; t < nt; t += 2) {
            const bool last = (t == nt - 2);
            const size_t o1 = (size_t)(t + 1) * kstep, o2 = (size_t)(t + 2) * kstep;
            const char* a1_1 = cq.a1 + o1;
            const char* a2_0 = last ? nq.a0 : cq.a0 + o2; const char* a2_1 = last ? nq.a1 : cq.a1 + o2;
            const char* b2_0 = last ? nq.b0 : cq.b0 + o2; const char* b2_1 = last ? nq.b1 : cq.b1 + o2;
            PG8_LDB(B0, 0, 0); PG8_LDB(B1, 0, 1); PG8_SCHED; PG8_LDA(At, 0, 0); PG8_STAGE(PG8_SA(1, 1), a1_1, voffA);
            PG8_WAIT_V(8); PG8_WAIT_L(0); PG8_BAR; PG8_MMA(0, 0, At, B0); PG8_MMA(0, 1, At, B1); PG8_BAR; PG8_SCHED;
            PG8_LDA(At, 0, 1); PG8_STAGE(PG8_SB(0, 0), b2_0, voffB); PG8_STAGE(PG8_SB(0, 1), b2_1, voffB); PG8_STAGE(PG8_SA(0, 0), a2_0, voffA);
            PG8_WAIT_V(8); PG8_WAIT_L(0); PG8_BAR; PG8_MMA(1, 0, At, B0); PG8_MMA(1, 1, At, B1); PG8_BAR; PG8_SCHED;
            PG8_LDB(B0, 1, 0); PG8_LDB(B1, 1, 1); PG8_SCHED; PG8_LDA(At, 1, 0); PG8_STAGE(PG8_SA(0, 1), a2_1, voffA);
            PG8_WAIT_V(8); PG8_WAIT_L(0); PG8_BAR; PG8_MMA(0, 0, At, B0); PG8_MMA(0, 1, At, B1); PG8_BAR; PG8_SCHED;
            PG8_LDA(At, 1, 1); PG8_STAGE(PG8_SB(1, 0), b2_0 + kstep, voffB); PG8_STAGE(PG8_SB(1, 1), b2_1 + kstep, voffB); PG8_STAGE(PG8_SA(1, 0), a2_0 + kstep, voffA);
            PG8_WAIT_V(8); PG8_WAIT_L(0); PG8_BAR; PG8_MMA(1, 0, At, B0); PG8_MMA(1, 1, At, B1); PG8_BAR; PG8_SCHED;
        }
        if (wr == 0) PG8_BAR;
        p.epi(acc, cur, wr, wc, fr, fq);
        if (!has_next) break;
#pragma unroll
        for (int a = 0; a < 2; ++a)
#pragma unroll
            for (int b = 0; b < 2; ++b)
#pragma unroll
                for (int m = 0; m < 4; ++m)
#pragma unroll
                    for (int n = 0; n < 2; ++n) acc[a][b][m][n] = (f32x4){0.f, 0.f, 0.f, 0.f};
        cur = nxt; cq = nq; ++ui;
        if (wr == 1) PG8_BAR;
    }
    PG8_WAIT_V(0);
    PG8_BAR;
#undef PG8_SA
#undef PG8_SB
#undef PG8_STAGE
#undef PG8_LDA
#undef PG8_LDB
#undef PG8_MMA
#undef PG8_WAIT_V
#undef PG8_WAIT_L
#undef PG8_BAR
#undef PG8_SCHED
}
}

#define XB_TMO      128
#define XB_XCNT(j)  (256  + 64 * (j))
#define XB_XSUB(j)  (1280 + 64 * (j))
#define XB_XGEN(j)  (2304 + 64 * (j))
#define XB_TOP      3328
#define XB_TOPGEN   3392
#define XCD_BAR_WORDS 3456
#define XB_SPIN_CAP (1u << 18)
__device__ __forceinline__ unsigned xb_ld(unsigned* p)              { return __hip_atomic_load(p, __ATOMIC_RELAXED, __HIP_MEMORY_SCOPE_AGENT); }
__device__ __forceinline__ unsigned xb_add(unsigned* p, unsigned v) { return __hip_atomic_fetch_add(p, v, __ATOMIC_RELAXED, __HIP_MEMORY_SCOPE_AGENT); }
__device__ __forceinline__ unsigned xb_xcc_id() { return (unsigned)__builtin_amdgcn_s_getreg((3 << 11) | 20) & 0xFu; }
#define XB_SPIN(cond, bar) do { unsigned _sp = 0; while (cond) { __builtin_amdgcn_s_sleep(1); \
    if ((++_sp & 255u) == 0u) { if (xb_ld(&(bar)[XB_TMO])) break; if (_sp > XB_SPIN_CAP) { atomicAdd(&(bar)[XB_TMO], 1u); break; } } } } while (0)
struct XcdBarrier { unsigned* bar; unsigned x; volatile LAS unsigned* st; };
__device__ __forceinline__ XcdBarrier xcd_barrier_post(unsigned* bar, volatile LAS unsigned* st) {
    XcdBarrier b; b.bar = bar; b.x = xb_xcc_id(); b.st = st;
    if (threadIdx.x == 0) (void)xb_add(&bar[XB_XCNT(b.x)], 1u);
    return b;
}
__device__ __forceinline__ void xcd_barrier_complete(unsigned* bar, unsigned x, unsigned& nloc, unsigned& nx) {
    const unsigned G = gridDim.x * gridDim.y * gridDim.z;
    unsigned sum, cnt, mine, sp = 0u;
    for (;;) {
        sum = 0u; cnt = 0u; mine = 0u;
#pragma unroll
        for (unsigned j = 0; j < 16; ++j) { const unsigned c = xb_ld(&bar[XB_XCNT(j)]); sum += c; cnt += (c > 0u) ? 1u : 0u; mine = (j == x) ? c : mine; }
        if (sum == G) break;
        __builtin_amdgcn_s_sleep(1);
        if ((++sp & 255u) == 0u) { if (xb_ld(&bar[XB_TMO])) break; if (sp > XB_SPIN_CAP) { atomicAdd(&bar[XB_TMO], 1u); break; } }
    }
    nloc = mine > 0u ? mine : 1u; nx = cnt > 0u ? cnt : 1u;
}
__device__ __forceinline__ void xcd_barrier(const XcdBarrier& b) {
    asm volatile("s_waitcnt vmcnt(0)" ::: "memory");
    __syncthreads();
    if (threadIdx.x == 0) {
        unsigned* bar = b.bar;
        __builtin_amdgcn_s_waitcnt(0);
        unsigned nloc = b.st[0], nx = b.st[1];
        if (nloc == 0u) { xcd_barrier_complete(bar, b.x, nloc, nx); b.st[0] = nloc; b.st[1] = nx; }
        const unsigned old = xb_add(&bar[XB_XSUB(b.x)], 1u);
        const unsigned gen = old / nloc;
        if (old + 1u == (gen + 1u) * nloc) {
            __builtin_amdgcn_fence(__ATOMIC_RELEASE, "agent");
            asm volatile("s_waitcnt vmcnt(0)" ::: "memory");
            const unsigned og = xb_add(&bar[XB_TOP], 1u);
            const unsigned tg = og / nx;
            if (og + 1u == (tg + 1u) * nx) xb_add(&bar[XB_TOPGEN], 1u);
            else XB_SPIN(xb_ld(&bar[XB_TOPGEN]) == tg, bar);
            __builtin_amdgcn_fence(__ATOMIC_ACQUIRE, "agent");
            xb_add(&bar[XB_XGEN(b.x)], 1u);
            asm volatile("s_waitcnt vmcnt(0)" ::: "memory");
        } else {
            XB_SPIN(xb_ld(&bar[XB_XGEN(b.x)]) == gen, bar);
            __builtin_amdgcn_fence(__ATOMIC_ACQUIRE, "agent");
            asm volatile("s_waitcnt vmcnt(0)" ::: "memory");
        }
    }
    __syncthreads();
}

struct Ctx { unsigned char* ws; const float* xp; const float* xs; float* out; int G, c; };

template <bool F16 = false, class F> __device__ __forceinline__ void epi_store_bf16(const f32x4 (&acc)[2][2][4][2], bf16_t* tile  , size_t ldc, const F& f, int ra = 128, int rm = 16) {
#pragma unroll
    for (int ai = 0; ai < 2; ++ai)
#pragma unroll
        for (int m = 0; m < 4; ++m) { bf16_t* rowp = tile + (size_t)(ai * ra + m * rm) * ldc;
#pragma unroll
            for (int bj = 0; bj < 2; ++bj) { f32x4 v0 = acc[ai][bj][m][0], v1 = acc[ai][bj][m][1];
                f(v0, v1, bj, ai * ra + m * rm);
                u32x4 w;
                if (F16) { w.x = cvt_pk_f16(v0[0], v0[1]); w.y = cvt_pk_f16(v0[2], v0[3]); w.z = cvt_pk_f16(v1[0], v1[1]); w.w = cvt_pk_f16(v1[2], v1[3]); }
                else { w.x = cvt_pk_bf16(v0[0], v0[1]); w.y = cvt_pk_bf16(v0[2], v0[3]); w.z = cvt_pk_bf16(v1[0], v1[1]); w.w = cvt_pk_bf16(v1[2], v1[3]); }
                *(u32x4*)(rowp + bj * 128) = w; } }
}
struct FIdent { __device__ __forceinline__ void operator()(f32x4&, f32x4&, int, int) const {} };
struct FSilu { float s; __device__ __forceinline__ void operator()(f32x4& a, f32x4& b, int, int) const {
#pragma unroll
    for (int e = 0; e < 4; ++e) { a[e] = fsilu(a[e]) * s; b[e] = fsilu(b[e]) * s; } } };
struct FLogF { f32x4 lb[2][2]; __device__ __forceinline__ void operator()(f32x4& a, f32x4& b, int bj, int) const {
#pragma unroll
    for (int e = 0; e < 4; ++e) { const float l0 = lb[bj][0][e], l1 = lb[bj][1][e];
        a[e] = l0 + (1.f - l0) * fsig(a[e]); b[e] = l1 + (1.f - l1) * fsig(b[e]); } } };

struct ProbG1a {
    static constexpr bool PERM = true;
    pg8::StaticOrder S; int lda, ldb, nt; unsigned char* ws;
    __device__ __forceinline__ void init(const Ctx& c) { S.init(TOK, 20480, c.G, c.c); lda = D; ldb = D; nt = D / 64; ws = c.ws; }
    __device__ __forceinline__ bool next(int i, pg8::Unit& u) const { return S.next(i, u); }
    __device__ __forceinline__ void ptrs(const pg8::Unit& u, pg8::Ptrs& q) const {
        q.a0 = (const char*)(ws + WS_H) + (size_t)u.pm * 256 * D * 2; q.a1 = q.a0 + (size_t)128 * D * 2;
        q.b0 = (const char*)(ws + WS_WIN) + (size_t)u.pn * 256 * D * 2; q.b1 = q.b0 + (size_t)128 * D * 2; }
    __device__ __forceinline__ void epi(const f32x4 (&acc)[2][2][4][2], const pg8::Unit& u, int wr, int wc, int fr, int fq) const {
        const int seg = u.pn >> 4, colt = (u.pn & 15) * 256 + wc * 32 + 8 * fq; int row0, L8; row_map(u.pm, wr, fr, row0, L8); const int ra = 4 * L8, rm = L8;
        bf16_t* tile = (bf16_t*)(ws + WS_Q + (size_t)seg * 256 * MiB) + (size_t)row0 * D + colt;
        if (seg == 0) { FSilu f{0.08838834764831845f}; epi_store_bf16(acc, tile, D, f, ra, rm); }
        else if (seg == 1 || seg == 2) { const float* lb = (const float*)(ws + (seg == 1 ? WS_LBF : WS_LBB)) + colt; FLogF f;
#pragma unroll
            for (int bj = 0; bj < 2; ++bj)
#pragma unroll
                for (int n = 0; n < 2; ++n) f.lb[bj][n] = *(const f32x4*)(lb + bj * 128 + 4 * n);
            epi_store_bf16<true>(acc, tile, D, f, ra, rm); }
        else if (seg == 3) { FIdent f; epi_store_bf16(acc, tile, D, f, ra, rm); }
        else { FSilu f{1.f}; epi_store_bf16(acc, tile, D, f, ra, rm); }
    }
};
struct ProbPlain {
    static constexpr bool PERM = true;
    pg8::StaticOrder S; int lda, ldb, nt; const char* A; const char* B; bf16_t* C; int ldc;
    __device__ __forceinline__ void init(const Ctx& c, const void* A_, const void* B_, void* C_, int N, int K) { S.init(TOK, N, c.G, c.c); lda = K; ldb = K; nt = K / 64; A = (const char*)A_; B = (const char*)B_; C = (bf16_t*)C_; ldc = N; }
    __device__ __forceinline__ bool next(int i, pg8::Unit& u) const { return S.next(i, u); }
    __device__ __forceinline__ void ptrs(const pg8::Unit& u, pg8::Ptrs& q) const {
        q.a0 = A + (size_t)u.pm * 256 * lda * 2; q.a1 = q.a0 + (size_t)128 * lda * 2; q.b0 = B + (size_t)u.pn * 256 * ldb * 2; q.b1 = q.b0 + (size_t)128 * ldb * 2; }
    __device__ __forceinline__ void epi(const f32x4 (&acc)[2][2][4][2], const pg8::Unit& u, int wr, int wc, int fr, int fq) const {
        bf16_t* tile = C + (size_t)(u.pm * 256 + wr * 64 + fr) * ldc + u.pn * 256 + wc * 32 + 8 * fq; FIdent f; epi_store_bf16(acc, tile, ldc, f); }
};
struct ProbG1b {
    static constexpr bool PERM = true;
    pg8::StaticOrder S; int lda, ldb, nt; unsigned char* ws;
    __device__ __forceinline__ void init(const Ctx& c) { S.init(TOK, 4096, c.G, c.c); lda = D; ldb = D; nt = D / 64; ws = c.ws; }
    __device__ __forceinline__ bool next(int i, pg8::Unit& u) const { return S.next(i, u); }
    __device__ __forceinline__ void ptrs(const pg8::Unit& u, pg8::Ptrs& q) const {
        q.a0 = (const char*)(ws + WS_H) + (size_t)u.pm * 256 * D * 2; q.a1 = q.a0 + (size_t)128 * D * 2;
        q.b0 = (const char*)(ws + WS_WIN) + (size_t)(C_U + u.pn * 256) * D * 2; q.b1 = q.b0 + (size_t)128 * D * 2; }
    __device__ __forceinline__ void epi(const f32x4 (&acc)[2][2][4][2], const pg8::Unit& u, int wr, int wc, int fr, int fq) const {
        int row0, L8; row_map(u.pm, wr, fr, row0, L8);
        if (u.pn >= 8) { const int colt = (u.pn & 7) * 256 + wc * 32 + 8 * fq; bf16_t* tile = (bf16_t*)(ws + WS_SGB) + (size_t)row0 * DB + colt; FSilu f{1.f}; epi_store_bf16(acc, tile, DB, f, 4 * L8, L8); return; }
        int seq0, lx; { if (u.pm < 64) { seq0 = (u.pm >> 5) * LP; lx = 32 * (u.pm & 31) + 16 * wr + fr; } else { const int ps = u.pm - 64; seq0 = NPT + (ps >> 3) * LSQ; lx = 32 * (ps & 7) + 16 * wr + fr; } }
        const float ph1 = (float)lx / (float)(8 * L8);
        const int g = u.pn >> 1, c0 = (u.pn & 1) * 256 + wc * 32 + 8 * fq;
        bf16_t* tb = (bf16_t*)(ws + WS_TU) + (size_t)(seq0 + lx) * 4096 + g * 1024 + c0;
        const float r2 = 0.70710678118654752f;
#pragma unroll
        for (int bj = 0; bj < 2; ++bj) {
#pragma unroll
            for (int n = 0; n < 2; ++n) {
                float er[4], ei[4], E0[4], E2[4], O0[4], O2[4], sv[4], dv[4];
#pragma unroll
                for (int e = 0; e < 4; ++e) {
                    const float u0 = acc[0][bj][0][n][e], u1 = acc[0][bj][1][n][e], u2 = acc[0][bj][2][n][e], u3 = acc[0][bj][3][n][e], u4 = acc[1][bj][0][n][e], u5 = acc[1][bj][1][n][e], u6 = acc[1][bj][2][n][e], u7 = acc[1][bj][3][n][e];
                    er[e] = u0 - u4; ei[e] = u6 - u2; E0[e] = (u0 + u4) + (u2 + u6); E2[e] = (u0 + u4) - (u2 + u6);
                    const float orr = u1 - u5, oi = u7 - u3; O0[e] = (u1 + u5) + (u3 + u7); O2[e] = (u1 + u5) - (u3 + u7);
                    sv[e] = (orr + oi) * r2; dv[e] = (oi - orr) * r2; }
#pragma unroll 1
                for (int k = 0; k < 8; ++k) {
                    float re[4], im[4]; const float tck = __builtin_amdgcn_cosf(ph1 * (float)k), tsk = __builtin_amdgcn_sinf(ph1 * (float)k);
#pragma unroll
                    for (int e = 0; e < 4; ++e) { float xr, xi;
                        if (k == 0) { xr = E0[e] + O0[e]; xi = 0.f; } else if (k == 4) { xr = E0[e] - O0[e]; xi = 0.f; }
                        else if (k == 2) { xr = E2[e]; xi = -O2[e]; } else if (k == 6) { xr = E2[e]; xi = O2[e]; }
                        else if (k == 1) { xr = er[e] + sv[e]; xi = ei[e] + dv[e]; } else if (k == 5) { xr = er[e] - sv[e]; xi = ei[e] - dv[e]; }
                        else if (k == 3) { xr = er[e] - sv[e]; xi = dv[e] - ei[e]; } else { xr = er[e] + sv[e]; xi = -ei[e] - dv[e]; }
                        re[e] = xr * tck + xi * tsk; im[e] = xi * tck - xr * tsk; }
                    const u32x2 wre = (u32x2){cvt_pk_bf16(re[0], re[1]), cvt_pk_bf16(re[2], re[3])}, wim = (u32x2){cvt_pk_bf16(im[0], im[1]), cvt_pk_bf16(im[2], im[3])};
                    bf16_t* o = tb + (size_t)k * L8 * 4096 + bj * 128 + 4 * n; *(u32x2*)o = wre; *(u32x2*)(o + 512) = wim;
                }
            }
        }
    }
};
struct ProbDft1 {
    static constexpr bool PERM = true;
    pg8::StaticOrder S; int lda, ldb, nt; unsigned char* ws;
    __device__ __forceinline__ void init(const Ctx& c) { S.init(4096, TOK, c.G, c.c); lda = 1024; ldb = 4096; nt = 16; ws = c.ws; }
    __device__ __forceinline__ bool next(int i, pg8::Unit& u) const { return S.next(i, u); }
    __device__ __forceinline__ void ptrs(const pg8::Unit& u, pg8::Ptrs& q) const {
        const int g = u.pm >> 2, pmr = u.pm & 3;
        q.a0 = (const char*)(ws + WS_DFTC) + (size_t)pmr * 256 * 1024 * 2; q.a1 = q.a0 + (size_t)128 * 1024 * 2;
        q.b0 = (const char*)(ws + WS_TU) + ((size_t)u.pn * 256 * 4096 + (size_t)g * 1024) * 2; q.b1 = q.b0 + (size_t)128 * 4096 * 2; }
    __device__ __forceinline__ void epi(const f32x4 (&acc)[2][2][4][2], const pg8::Unit& u, int wr, int wc, int fr, int fq) const {
        const int g = u.pm >> 2, pmr = u.pm & 3, part = pmr >> 1, j0 = (pmr & 1) * 256 + wr * 64 + fr;
        const int tt = u.pn; size_t base; int L8, ky, l0;
        if (tt < 64) { L8 = LP / 8; base = (size_t)(tt >> 5) * ABT_SEQ_P; ky = (tt & 31) >> 2; l0 = (tt & 3) * 256; }
        else { const int ts = tt - 64; L8 = LSQ / 8; base = 2 * ABT_SEQ_P + (size_t)(ts >> 3) * ABT_SEQ_S; ky = ts & 7; l0 = 0; }
        bf16_t* tile = (bf16_t*)(ws + WS_ABT) + base + ((size_t)(ky * 2048 + g * CG + j0) * 2 + part) * L8 + l0 + wc * 32 + 8 * fq;
        FIdent f; epi_store_bf16(acc, tile, (size_t)2 * L8, f);
    }
};
struct FMulG { const bf16_t* g; __device__ __forceinline__ void operator()(f32x4& a, f32x4& b, int bj, int roff) const {
    const u32x4 w = *(const u32x4*)(g + (size_t)roff * DB + bj * 128);
    a[0] *= bf_lo(w.x); a[1] *= bf_hi(w.x); a[2] *= bf_lo(w.y); a[3] *= bf_hi(w.y); b[0] *= bf_lo(w.z); b[1] *= bf_hi(w.z); b[2] *= bf_lo(w.w); b[3] *= bf_hi(w.w); } };
struct ProbDft2 {
    static constexpr bool PERM = true;
    pg8::StaticOrder S; int lda, ldb, nt; unsigned char* ws; int L8, lshift; size_t abt_off, abt_seq, dfts_off; int tok0, L;
    __device__ __forceinline__ void init(const Ctx& c, int sample) { S.init(2048, 16384, c.G, c.c); ws = c.ws;
        if (!sample) { L8 = LP / 8; lshift = 2; abt_off = 0; abt_seq = ABT_SEQ_P; dfts_off = WS_DFTS; tok0 = 0; L = LP; } else { L8 = LSQ / 8; lshift = 0; abt_off = 2 * ABT_SEQ_P; abt_seq = ABT_SEQ_S; dfts_off = WS_DFTS_S; tok0 = NPT; L = LSQ; }
        lda = 2 * L8; ldb = 2 * L8; nt = 2 * L8 / 64; }
    __device__ __forceinline__ bool next(int i, pg8::Unit& u) const { return S.next(i, u); }
    __device__ __forceinline__ void ptrs(const pg8::Unit& u, pg8::Ptrs& q) const {
        const int b = u.pm >> lshift, pml = u.pm & ((1 << lshift) - 1);
        q.a0 = (const char*)(ws + dfts_off) + (size_t)pml * 256 * (2 * L8) * 2; q.a1 = q.a0 + (size_t)128 * (2 * L8) * 2;
        q.b0 = (const char*)(ws + WS_ABT) + (abt_off + (size_t)b * abt_seq + (size_t)u.pn * 256 * (2 * L8)) * 2; q.b1 = q.b0 + (size_t)128 * (2 * L8) * 2; }
    __device__ __forceinline__ void epi(const f32x4 (&acc)[2][2][4][2], const pg8::Unit& u, int wr, int wc, int fr, int fq) const {
        const int b = u.pm >> lshift, pml = u.pm & ((1 << lshift) - 1), ky = u.pn >> 3, kx0 = pml * 256 + wr * 64 + fr;
        const size_t off = (size_t)(tok0 + b * L + 8 * kx0 + ky) * DB + (u.pn & 7) * 256 + wc * 32 + 8 * fq;
        FMulG f{(const bf16_t*)(ws + WS_SGB) + off}; epi_store_bf16(acc, (bf16_t*)(ws + WS_BOUT) + off, DB, f, 1024, 128);
    }
};
struct ProbMerge {
    static constexpr bool PERM = true;
    pg8::StaticOrder S; int lda, ldb, nt; unsigned char* ws;
    __device__ __forceinline__ void init(const Ctx& c) { S.init(TOK, 8192, c.G, c.c); lda = D; ldb = D; nt = D / 64; ws = c.ws; }
    __device__ __forceinline__ bool next(int i, pg8::Unit& u) const { return S.next(i, u); }
    __device__ __forceinline__ void ptrs(const pg8::Unit& u, pg8::Ptrs& q) const {
        q.a0 = (const char*)(ws + WS_H) + (size_t)u.pm * 256 * D * 2; q.a1 = q.a0 + (size_t)128 * D * 2;
        q.b0 = (const char*)(ws + WS_WIN) + (size_t)(C_MA + u.pn * 128) * D * 2; q.b1 = (const char*)(ws + WS_WIN) + (size_t)(C_MB + u.pn * 128) * D * 2; }
    __device__ __forceinline__ void epi(const f32x4 (&acc)[2][2][4][2], const pg8::Unit& u, int wr, int wc, int fr, int fq) const {
        int row0, L8; row_map(u.pm, wr, fr, row0, L8);
        const size_t off0 = (size_t)row0 * D + u.pn * 128 + wc * 32 + 8 * fq;
        const bf16_t* pa = (const bf16_t*)(ws + WS_PA) + off0; const bf16_t* pb = (const bf16_t*)(ws + WS_PB) + off0; bf16_t* mo = (bf16_t*)(ws + WS_M) + off0;
#pragma unroll
        for (int ai = 0; ai < 2; ++ai)
#pragma unroll
            for (int m = 0; m < 4; ++m) { const size_t ro = (size_t)((4 * ai + m) * L8) * D;
                const u32x4 wa = *(const u32x4*)(pa + ro), wb = *(const u32x4*)(pb + ro);
                const f32x4 a0 = acc[ai][0][m][0], a1 = acc[ai][0][m][1], b0 = acc[ai][1][m][0], b1 = acc[ai][1][m][1];
                float r[8];
                r[0] = fsig(a0[0]) * bf_lo(wa.x) + fsig(b0[0]) * bf_lo(wb.x); r[1] = fsig(a0[1]) * bf_hi(wa.x) + fsig(b0[1]) * bf_hi(wb.x);
                r[2] = fsig(a0[2]) * bf_lo(wa.y) + fsig(b0[2]) * bf_lo(wb.y); r[3] = fsig(a0[3]) * bf_hi(wa.y) + fsig(b0[3]) * bf_hi(wb.y);
                r[4] = fsig(a1[0]) * bf_lo(wa.z) + fsig(b1[0]) * bf_lo(wb.z); r[5] = fsig(a1[1]) * bf_hi(wa.z) + fsig(b1[1]) * bf_hi(wb.z);
                r[6] = fsig(a1[2]) * bf_lo(wa.w) + fsig(b1[2]) * bf_lo(wb.w); r[7] = fsig(a1[3]) * bf_hi(wa.w) + fsig(b1[3]) * bf_hi(wb.w);
                u32x4 w; w.x = cvt_pk_bf16(r[0], r[1]); w.y = cvt_pk_bf16(r[2], r[3]); w.z = cvt_pk_bf16(r[4], r[5]); w.w = cvt_pk_bf16(r[6], r[7]);
                *(u32x4*)(mo + ro) = w; }
    }
};
struct ProbOut {
    static constexpr bool PERM = false;
    pg8::StaticOrder S; int lda, ldb, nt; unsigned char* ws; const float* xp; const float* xs; float* out;
    __device__ __forceinline__ void init(const Ctx& c) { S.init(TOK, D, c.G, c.c); lda = D; ldb = D; nt = D / 64; ws = c.ws; xp = c.xp; xs = c.xs; out = c.out; }
    __device__ __forceinline__ bool next(int i, pg8::Unit& u) const { return S.next(i, u); }
    __device__ __forceinline__ void ptrs(const pg8::Unit& u, pg8::Ptrs& q) const {
        q.a0 = (const char*)(ws + WS_M) + (size_t)u.pm * 256 * D * 2; q.a1 = q.a0 + (size_t)128 * D * 2;
        q.b0 = (const char*)(ws + WS_WO) + (size_t)u.pn * 256 * D * 2; q.b1 = q.b0 + (size_t)128 * D * 2; }
    __device__ __forceinline__ void epi(const f32x4 (&acc)[2][2][4][2], const pg8::Unit& u, int wr, int wc, int fr, int fq) const {
        const int row0 = u.pm * 256 + wr * 64 + fr, col0 = u.pn * 256 + wc * 32 + 4 * fq;
        const float* xb = (u.pm < 64) ? xp + (size_t)row0 * D : xs + (size_t)(row0 - NPT) * D;
        float* ob = out + (size_t)row0 * D;
#pragma unroll
        for (int ai = 0; ai < 2; ++ai)
#pragma unroll
            for (int m = 0; m < 4; ++m) { const size_t ro = (size_t)(ai * 128 + m * 16) * D + col0;
#pragma unroll
                for (int bj = 0; bj < 2; ++bj)
#pragma unroll
                    for (int n = 0; n < 2; ++n) { const f32x4 xv = *(const f32x4*)(xb + ro + bj * 128 + n * 16); *(f32x4*)(ob + ro + bj * 128 + n * 16) = acc[ai][bj][m][n] + xv; } }
    }
};

__device__ __forceinline__ unsigned f2bf(float f) { unsigned u = __builtin_bit_cast(unsigned, f); return (u + 0x7fffu + ((u >> 16) & 1u)) >> 16; }
__device__ __forceinline__ unsigned pk2(float lo, float hi) { return f2bf(lo) | (f2bf(hi) << 16); }
__device__ __forceinline__ void p0_transpose_item(const float* W, int K, int N, bf16_t* WT, LAS float* scr, int item, int lane) {
    const int nblk = N / 32, kb = item / nblk, nb = item % nblk, k0 = 64 * kb, n0 = 32 * nb;
#pragma unroll 8
    for (int i = 0; i < 32; ++i) { const int kk = 2 * i + (lane >> 5); scr[kk * 33 + (lane & 31)] = W[(size_t)(k0 + kk) * N + n0 + (lane & 31)]; }
    LDS_WAIT(); asm volatile("" ::: "memory");
    const int c = lane & 7;
#pragma unroll
    for (int j = 0; j < 4; ++j) { const int n = (lane >> 3) + 8 * j; const LAS float* s = scr + (8 * c) * 33 + n;
        u32x4 o; o.x = pk2(s[0 * 33], s[1 * 33]); o.y = pk2(s[2 * 33], s[3 * 33]); o.z = pk2(s[4 * 33], s[5 * 33]); o.w = pk2(s[6 * 33], s[7 * 33]);
        *(u32x4*)(WT + (size_t)(n0 + n) * K + k0 + 8 * c) = o; }
    LDS_WAIT(); asm volatile("" ::: "memory");
}
template <bool OUT_BF16> __device__ __forceinline__ void rms_row(const float* xrow, const float* g, void* orow, int lane) {
    const f32x4* xr = (const f32x4*)xrow + lane;
    f32x4 v[16]; float s = 0.f;
#pragma unroll
    for (int j = 0; j < 16; ++j) { v[j] = xr[64 * j]; s += (v[j].x * v[j].x + v[j].y * v[j].y) + (v[j].z * v[j].z + v[j].w * v[j].w); }
    const float rstd = 1.0f / sqrtf(wave_sum(s) * (1.f / D) + EPS);
    const f32x4* gr = (const f32x4*)g + lane;
#pragma unroll
    for (int j = 0; j < 16; ++j) { const f32x4 gv = gr[64 * j]; const f32x4 y = v[j] * rstd * gv;
        if (OUT_BF16) { u32x2 w; w.x = cvt_pk_bf16(y.x, y.y); w.y = cvt_pk_bf16(y.z, y.w); ((u32x2*)orow)[lane + 64 * j] = w; }
        else ((f32x4*)orow)[lane + 64 * j] = y; }
}

struct Args { const float* in[11]; float* out; unsigned char* ws; int ph_lo, ph_hi; };

__device__ __forceinline__ void gla_pair_info(int p, int& tok0, int& L, int& h) { h = p & 31; if (p < 64) { tok0 = (p >> 5) * LP; L = LP; } else { tok0 = NPT + ((p - 64) >> 5) * LSQ; L = LSQ; } }

#if GLA_NAIVE
__device__ __forceinline__ void gla_pair_naive(LAS unsigned char* lds, unsigned char* ws, const float* ghead, int p) {
    const int tid = threadIdx.x, lane = tid & 63, wave = tid >> 6;
    int tok0, L, h; gla_pair_info(p, tok0, L, h);
    const bf16_t* Q = (const bf16_t*)(ws + WS_Q); bf16_t* KF = (bf16_t*)(ws + WS_KF); const bf16_t* KB = (const bf16_t*)(ws + WS_KB);
    const bf16_t* V = (const bf16_t*)(ws + WS_V); bf16_t* GA = (bf16_t*)(ws + WS_GA);
    LAS float* Lq = (LAS float*)lds; LAS float* Lf = Lq + 16 * 128; LAS float* Lk = Lf + 16 * 128; LAS float* Lv = Lk + 16 * 128; LAS float* Lo = Lv + 16 * 128;
    const int v = tid & 127, kq = tid >> 7;
    for (int pass = 0; pass < 2; ++pass) {
        float S[32];
#pragma unroll
        for (int i = 0; i < 32; ++i) S[i] = 0.f;
        const bf16_t* F = pass ? KB : (const bf16_t*)KF;
        for (int blk = 0; blk < L / 16; ++blk) {
            { const int i = tid >> 5, c4 = (tid & 31) * 4; const int tau = blk * 16 + i; const int t = tok0 + (pass ? (L - 1 - tau) : tau);
              const size_t off = (size_t)t * D + h * DH + c4;
              const u32x2 wq = *(const u32x2*)(Q + off), wf = *(const u32x2*)(F + off), wv = *(const u32x2*)(V + off);
              const float lf0 = bf_lo(wf.x), lf1 = bf_hi(wf.x), lf2 = bf_lo(wf.y), lf3 = bf_hi(wf.y);
              const float f0 = fexp(lf0), f1 = fexp(lf1), f2 = fexp(lf2), f3 = fexp(lf3);
              *(LAS f32x4*)(Lq + i * 128 + c4) = (f32x4){bf_lo(wq.x), bf_hi(wq.x), bf_lo(wq.y), bf_hi(wq.y)};
              *(LAS f32x4*)(Lf + i * 128 + c4) = (f32x4){f0, f1, f2, f3};
              *(LAS f32x4*)(Lk + i * 128 + c4) = (f32x4){1.f - f0, 1.f - f1, 1.f - f2, 1.f - f3};
              *(LAS f32x4*)(Lv + i * 128 + c4) = (f32x4){bf_lo(wv.x), bf_hi(wv.x), bf_lo(wv.y), bf_hi(wv.y)}; }
            __syncthreads();
            for (int i = 0; i < 16; ++i) {
                const float vv = Lv[i * 128 + v]; float op = 0.f;
#pragma unroll
                for (int k4 = 0; k4 < 8; ++k4) {
                    const f32x4 f = *(const LAS f32x4*)(Lf + i * 128 + kq * 32 + k4 * 4), kx = *(const LAS f32x4*)(Lk + i * 128 + kq * 32 + k4 * 4), qx = *(const LAS f32x4*)(Lq + i * 128 + kq * 32 + k4 * 4);
#pragma unroll
                    for (int e = 0; e < 4; ++e) { S[k4 * 4 + e] = f[e] * S[k4 * 4 + e] + kx[e] * vv; op += S[k4 * 4 + e] * qx[e]; }
                }
                Lo[(i * 4 + kq) * 128 + v] = op;
            }
            __syncthreads();
#pragma unroll
            for (int j = 0; j < 2; ++j) { const int i = 2 * wave + j; const int tau = blk * 16 + i; const int t = tok0 + (pass ? (L - 1 - tau) : tau);
                const size_t off = (size_t)t * D + h * DH + 2 * lane;
                float o0 = 0.f, o1 = 0.f;
#pragma unroll
                for (int q = 0; q < 4; ++q) { const f32x2 x = *(const LAS f32x2*)(Lo + (i * 4 + q) * 128 + 2 * lane); o0 += x.x; o1 += x.y; }
                if (pass == 0) { *(unsigned*)(KF + off) = cvt_pk_bf16(o0, o1); }
                else { const unsigned wf = *(const unsigned*)(KF + off), wg = *(const unsigned*)(GA + off);
                    o0 += bf_lo(wf); o1 += bf_hi(wf);
                    const float ss = wave_sum(o0 * o0 + o1 * o1); const float rstd = 1.0f / sqrtf(ss * (1.f / DH) + EPS);
                    const f32x2 gh = *(const f32x2*)(ghead + h * DH + 2 * lane);
                    *(unsigned*)(GA + off) = cvt_pk_bf16(o0 * rstd * gh.x * bf_lo(wg), o1 * rstd * gh.y * bf_hi(wg)); }
            }
            __syncthreads();
        }
        VM_WAIT(); __syncthreads(); __builtin_amdgcn_fence(__ATOMIC_ACQUIRE, "agent"); VM_WAIT(); __syncthreads();
    }
}
#endif

constexpr int GL_QH = 0, GL_KT = 17408, GL_KTT = 34816, GL_VT = 53248, GL_ST = 71680, GL_SEG = 106496, GL_DV = 110592, GL_GH = 111104;
#define LBAR() do { asm volatile("s_waitcnt lgkmcnt(0)" ::: "memory"); __builtin_amdgcn_s_barrier(); asm volatile("" ::: "memory"); } while (0)
#define MFMA32(a, b, c) __builtin_amdgcn_mfma_f32_32x32x16_bf16((a), (b), (c), 0, 0, 0)
template <int PASS>
__device__ __forceinline__ void gla_pass(LAS unsigned char* lds, unsigned char* ws, const float* ghead, int tok0, int L, int h) {
    const int tid = threadIdx.x, lane = tid & 63, wave = __builtin_amdgcn_readfirstlane(tid >> 6);
    const int nchunk = L >> 6, tq = wave >> 2, vt = wave & 3, l31 = lane & 31, hh = lane >> 5;
    const size_t colo = (size_t)h * DH + 2 * lane;
    const bf16_t* Q = (const bf16_t*)(ws + WS_Q) + colo; const bf16_t* F = (const bf16_t*)(ws + (PASS ? WS_KB : WS_KF)) + colo; const bf16_t* V = (const bf16_t*)(ws + WS_V) + colo;
    const int er = lane >> 3, ec = (lane & 7) * 16;
    bf16_t* KFe = (bf16_t*)(ws + WS_KF) + (size_t)h * DH + ec; bf16_t* GAe = (bf16_t*)(ws + WS_GA) + (size_t)h * DH + ec;
    if (PASS && tid < 32) *(LAS f32x4*)(lds + GL_GH + tid * 16) = *(const f32x4*)(ghead + h * DH + tid * 4);
    const long stp = PASS ? -1 : 1;
    f32x16 s0, s1;
#pragma unroll
    for (int i = 0; i < 16; ++i) { s0[i] = 0.f; s1[i] = 0.f; }
    for (int i = tid; i < 34816 / 16; i += 512) ((LAS u32x4*)(lds + GL_ST))[i] = (u32x4){0u, 0u, 0u, 0u};
    unsigned cq[8], cf[8], cv[8];
    { const int tau0 = 8 * wave; const long t0 = tok0 + (PASS ? (L - 1 - tau0) : tau0);
#pragma unroll
      for (int i = 0; i < 8; ++i) { const size_t ro = (size_t)(t0 + stp * i) * D; cq[i] = *(const unsigned*)(Q + ro); cf[i] = *(const unsigned*)(F + ro); cv[i] = *(const unsigned*)(V + ro); } }
    for (int c = 0; c < nchunk; ++c) {
        const int tau0 = 64 * c + 8 * wave; const long t0 = tok0 + (PASS ? (L - 1 - tau0) : tau0);
        const int adv = (c + 1 < nchunk) ? 64 : 0;
        unsigned nq[8], nf[8], nv[8];
#pragma unroll
        for (int i = 0; i < 8; ++i) { const size_t ro = (size_t)(t0 + stp * (adv + i)) * D; nq[i] = *(const unsigned*)(Q + ro); nf[i] = *(const unsigned*)(F + ro); nv[i] = *(const unsigned*)(V + ro); }
        const size_t ero = (size_t)(t0 + stp * er) * D;
        u32x4 wof[2], wga[2];
        if (PASS) { wof[0] = *(const u32x4*)(KFe + ero); wof[1] = *(const u32x4*)(KFe + ero + 8); wga[0] = *(const u32x4*)(GAe + ero); wga[1] = *(const u32x4*)(GAe + ero + 8); }
        float f0[8], f1[8], e0[8], e1[8]; { float r0 = 1.f, r1 = 1.f;
#pragma unroll
            for (int i = 0; i < 8; ++i) { const f32x2 fv = unpk_f16(cf[i]); f0[i] = fv.x; f1[i] = fv.y; r0 *= fv.x; r1 *= fv.y; e0[i] = r0; e1[i] = r1; }
            *(LAS f32x2*)(lds + GL_SEG + (wave * 128 + 2 * lane) * 4) = (f32x2){r0, r1}; }
        LBAR();
        { float p0 = 1.f, p1 = 1.f;
#pragma unroll
          for (int w = 0; w < 7; ++w) if (w < wave) { const f32x2 x = *(const LAS f32x2*)(lds + GL_SEG + (w * 128 + 2 * lane) * 4); p0 *= x.x; p1 *= x.y; }
          unsigned kc0[4], kc1[4], vc0[4], vc1[4]; float kp0 = 0.f, kp1 = 0.f;
#pragma unroll
          for (int i = 0; i < 8; ++i) { const float ee0 = e0[i] * p0, ee1 = e1[i] * p1;
              const float q0 = bf_lo(cq[i]) * ee0, q1 = bf_hi(cq[i]) * ee1;
              const float k0 = (1.f - f0[i]) * frcp(ee0), k1 = (1.f - f1[i]) * frcp(ee1);
              *(LAS unsigned*)(lds + GL_QH + (8 * wave + i) * 272 + 4 * lane) = cvt_pk_bf16(q0, q1);
              *(LAS unsigned*)(lds + GL_KT + (8 * wave + i) * 272 + 4 * lane) = cvt_pk_bf16(k0, k1);
              if (i & 1) { kc0[i >> 1] = cvt_pk_bf16(kp0, k0); kc1[i >> 1] = cvt_pk_bf16(kp1, k1); vc0[i >> 1] = (cv[i - 1] & 0xffffu) | (cv[i] << 16); vc1[i >> 1] = (cv[i - 1] >> 16) | (cv[i] & 0xffff0000u); }
              else { kp0 = k0; kp1 = k1; } }
          if (wave == 7) *(LAS f32x2*)(lds + GL_DV + 2 * lane * 4) = (f32x2){e0[7] * p0, e1[7] * p1};
          *(LAS u32x4*)(lds + GL_KTT + (2 * lane) * 144 + 16 * wave) = (u32x4){kc0[0], kc0[1], kc0[2], kc0[3]};
          *(LAS u32x4*)(lds + GL_KTT + (2 * lane + 1) * 144 + 16 * wave) = (u32x4){kc1[0], kc1[1], kc1[2], kc1[3]};
          *(LAS u32x4*)(lds + GL_VT + (2 * lane) * 144 + 16 * wave) = (u32x4){vc0[0], vc0[1], vc0[2], vc0[3]};
          *(LAS u32x4*)(lds + GL_VT + (2 * lane + 1) * 144 + 16 * wave) = (u32x4){vc1[0], vc1[1], vc1[2], vc1[3]}; }
        LBAR();
        f32x16 oacc;
#pragma unroll
        for (int i = 0; i < 16; ++i) oacc[i] = 0.f;
        bf16x8 qf[8];
#pragma unroll
        for (int kh = 0; kh < 2; ++kh) { bf16x8 sb[4];
#pragma unroll
          for (int k4 = 0; k4 < 4; ++k4) { const int ks = 4 * kh + k4; qf[ks] = *(const LAS bf16x8*)(lds + GL_QH + (32 * tq + l31) * 272 + hh * 16 + ks * 32); sb[k4] = *(const LAS bf16x8*)(lds + GL_ST + (32 * vt + l31) * 272 + hh * 16 + ks * 32); }
          __builtin_amdgcn_sched_barrier(0);
#pragma unroll
          for (int k4 = 0; k4 < 4; ++k4) oacc = MFMA32(qf[4 * kh + k4], sb[k4], oacc); }
#pragma unroll
        for (int kh = 0; kh < 2; ++kh) { bf16x8 vb[2], ka0[2], ka1[2];
#pragma unroll
          for (int k2 = 0; k2 < 2; ++k2) { const int ks = 2 * kh + k2; vb[k2] = *(const LAS bf16x8*)(lds + GL_VT + (32 * vt + l31) * 144 + hh * 16 + ks * 32);
              ka0[k2] = *(const LAS bf16x8*)(lds + GL_KTT + (64 * tq + l31) * 144 + hh * 16 + ks * 32); ka1[k2] = *(const LAS bf16x8*)(lds + GL_KTT + (64 * tq + 32 + l31) * 144 + hh * 16 + ks * 32); }
          __builtin_amdgcn_sched_barrier(0);
#pragma unroll
          for (int k2 = 0; k2 < 2; ++k2) { s0 = MFMA32(ka0[k2], vb[k2], s0); s1 = MFMA32(ka1[k2], vb[k2], s1); } }
        for (int st = 0; st <= tq; ++st) {
            f32x16 x;
#pragma unroll
            for (int i = 0; i < 16; ++i) x[i] = 0.f;
            u32x2 blo[2], bhi[2];
#pragma unroll
            for (int kh = 0; kh < 2; ++kh) { bf16x8 ka[4];
#pragma unroll
              for (int k4 = 0; k4 < 4; ++k4) ka[k4] = *(const LAS bf16x8*)(lds + GL_KT + (32 * st + l31) * 272 + hh * 16 + (4 * kh + k4) * 32);
              if (kh == 1) {
#pragma unroll
                  for (int sp = 0; sp < 2; ++sp) { const LAS unsigned char* vp = lds + GL_VT + (32 * vt + l31) * 144 + 64 * st + 32 * sp + 8 * hh; blo[sp] = *(const LAS u32x2*)vp; bhi[sp] = *(const LAS u32x2*)(vp + 16); } }
              __builtin_amdgcn_sched_barrier(0);
#pragma unroll
              for (int k4 = 0; k4 < 4; ++k4) x = MFMA32(ka[k4], qf[4 * kh + k4], x); }
            if (st == tq) {
#pragma unroll
                for (int r = 0; r < 16; ++r) { const int sl = (r & 3) + 8 * (r >> 2) + 4 * hh; x[r] = (sl <= l31) ? x[r] : 0.f; }
            }
#pragma unroll
            for (int sp = 0; sp < 2; ++sp) {
                u32x4 aw; aw.x = cvt_pk_bf16(x[8 * sp + 0], x[8 * sp + 1]); aw.y = cvt_pk_bf16(x[8 * sp + 2], x[8 * sp + 3]); aw.z = cvt_pk_bf16(x[8 * sp + 4], x[8 * sp + 5]); aw.w = cvt_pk_bf16(x[8 * sp + 6], x[8 * sp + 7]);
                const u32x4 bw = (u32x4){blo[sp].x, blo[sp].y, bhi[sp].x, bhi[sp].y};
                oacc = MFMA32(__builtin_bit_cast(bf16x8, aw), __builtin_bit_cast(bf16x8, bw), oacc);
            }
        }
#pragma unroll
        for (int g = 0; g < 4; ++g) { const f32x4 d0 = *(const LAS f32x4*)(lds + GL_DV + (64 * tq + 8 * g + 4 * hh) * 4), d1 = *(const LAS f32x4*)(lds + GL_DV + (64 * tq + 32 + 8 * g + 4 * hh) * 4);
#pragma unroll
            for (int e = 0; e < 4; ++e) { s0[4 * g + e] *= d0[e]; s1[4 * g + e] *= d1[e]; } }
        LBAR();
#pragma unroll
        for (int r = 0; r < 16; ++r) { const int tl = (r & 3) + 8 * (r >> 2) + 4 * hh; *(LAS float*)(lds + ((32 * tq + tl) * 132 + 32 * vt + l31) * 4) = oacc[r]; }
#pragma unroll
        for (int g = 0; g < 4; ++g) {
            *(LAS u32x2*)(lds + GL_ST + (32 * vt + l31) * 272 + (64 * tq + 8 * g + 4 * hh) * 2) = (u32x2){cvt_pk_bf16(s0[4 * g], s0[4 * g + 1]), cvt_pk_bf16(s0[4 * g + 2], s0[4 * g + 3])};
            *(LAS u32x2*)(lds + GL_ST + (32 * vt + l31) * 272 + (64 * tq + 32 + 8 * g + 4 * hh) * 2) = (u32x2){cvt_pk_bf16(s1[4 * g], s1[4 * g + 1]), cvt_pk_bf16(s1[4 * g + 2], s1[4 * g + 3])}; }
        LBAR();
        { f32x4 o4[4];
#pragma unroll
          for (int j = 0; j < 4; ++j) o4[j] = *(const LAS f32x4*)(lds + ((8 * wave + er) * 132 + ec + 4 * j) * 4);
          if (PASS == 0) {
              u32x4 w0, w1; w0.x = cvt_pk_bf16(o4[0].x, o4[0].y); w0.y = cvt_pk_bf16(o4[0].z, o4[0].w); w0.z = cvt_pk_bf16(o4[1].x, o4[1].y); w0.w = cvt_pk_bf16(o4[1].z, o4[1].w);
              w1.x = cvt_pk_bf16(o4[2].x, o4[2].y); w1.y = cvt_pk_bf16(o4[2].z, o4[2].w); w1.z = cvt_pk_bf16(o4[3].x, o4[3].y); w1.w = cvt_pk_bf16(o4[3].z, o4[3].w);
              *(u32x4*)(KFe + ero) = w0; *(u32x4*)(KFe + ero + 8) = w1;
          } else {
              o4[0] += (f32x4){bf_lo(wof[0].x), bf_hi(wof[0].x), bf_lo(wof[0].y), bf_hi(wof[0].y)}; o4[1] += (f32x4){bf_lo(wof[0].z), bf_hi(wof[0].z), bf_lo(wof[0].w), bf_hi(wof[0].w)};
              o4[2] += (f32x4){bf_lo(wof[1].x), bf_hi(wof[1].x), bf_lo(wof[1].y), bf_hi(wof[1].y)}; o4[3] += (f32x4){bf_lo(wof[1].z), bf_hi(wof[1].z), bf_lo(wof[1].w), bf_hi(wof[1].w)};
              float ss = 0.f;
#pragma unroll
              for (int j = 0; j < 4; ++j) ss += (o4[j].x * o4[j].x + o4[j].y * o4[j].y) + (o4[j].z * o4[j].z + o4[j].w * o4[j].w);
              ss += __shfl_xor(ss, 1); ss += __shfl_xor(ss, 2); ss += __shfl_xor(ss, 4);
              const float rstd = 1.0f / sqrtf(ss * (1.f / DH) + EPS);
#pragma unroll
              for (int j = 0; j < 4; ++j) o4[j] = o4[j] * rstd * *(const LAS f32x4*)(lds + GL_GH + (ec + 4 * j) * 4);
              u32x4 w0, w1;
              w0.x = cvt_pk_bf16(o4[0].x * bf_lo(wga[0].x), o4[0].y * bf_hi(wga[0].x)); w0.y = cvt_pk_bf16(o4[0].z * bf_lo(wga[0].y), o4[0].w * bf_hi(wga[0].y));
              w0.z = cvt_pk_bf16(o4[1].x * bf_lo(wga[0].z), o4[1].y * bf_hi(wga[0].z)); w0.w = cvt_pk_bf16(o4[1].z * bf_lo(wga[0].w), o4[1].w * bf_hi(wga[0].w));
              w1.x = cvt_pk_bf16(o4[2].x * bf_lo(wga[1].x), o4[2].y * bf_hi(wga[1].x)); w1.y = cvt_pk_bf16(o4[2].z * bf_lo(wga[1].y), o4[2].w * bf_hi(wga[1].y));
              w1.z = cvt_pk_bf16(o4[3].x * bf_lo(wga[1].z), o4[3].y * bf_hi(wga[1].z)); w1.w = cvt_pk_bf16(o4[3].z * bf_lo(wga[1].w), o4[3].w * bf_hi(wga[1].w));
              *(u32x4*)(GAe + ero) = w0; *(u32x4*)(GAe + ero + 8) = w1;
          } }
#pragma unroll
        for (int i = 0; i < 8; ++i) { asm volatile("" : "+v"(nq[i]), "+v"(nf[i]), "+v"(nv[i])); cq[i] = nq[i]; cf[i] = nf[i]; cv[i] = nv[i]; }
    }
    VM_WAIT(); __syncthreads(); __builtin_amdgcn_fence(__ATOMIC_ACQUIRE, "agent"); VM_WAIT(); __syncthreads();
}
__device__ __forceinline__ void gla_pair_mfma(LAS unsigned char* lds, unsigned char* ws, const float* ghead, int p) {
    int tok0, L, h; gla_pair_info(p, tok0, L, h);
    gla_pass<0>(lds, ws, ghead, tok0, L, h);
    gla_pass<1>(lds, ws, ghead, tok0, L, h);
}

__device__ __forceinline__ void gla_phase(LAS unsigned char* lds, unsigned char* ws, const float* ghead, int vcu, int G) {
#if GLA_NAIVE
#define GLA_PAIR gla_pair_naive
#else
#define GLA_PAIR gla_pair_mfma
#endif
    if (G == 256) { GLA_PAIR(lds, ws, ghead, vcu); if (vcu >= 64 && vcu < 128) GLA_PAIR(lds, ws, ghead, vcu + 192); }
    else { for (int p = vcu; p < 320; p += G) GLA_PAIR(lds, ws, ghead, p); }
}

__device__ __forceinline__ void p0_body(const Args& args, unsigned char* ws, LAS unsigned char* lds, int G, int bx, int tid, int lane, int wave, int gw, int NGW) {
        LAS float* scr = (LAS float*)(lds + wave * 16384);
        const float* w_in = args.in[3]; const float* w_a = args.in[7]; const float* w_b = args.in[8]; const float* w_o = args.in[9];
        constexpr int I_IN = (D / 64) * (32768 / 32), I_A = (D / 64) * (D / 32), I_B = (DB / 64) * (D / 32), I_O = I_A;
        for (int it = gw; it < I_IN + I_A + I_B + I_O; it += NGW) {
            int r = it;
            if (r < I_IN) { p0_transpose_item(w_in, D, 32768, (bf16_t*)(ws + WS_WIN), scr, r, lane); continue; } r -= I_IN;
            if (r < I_A) { p0_transpose_item(w_a, D, D, (bf16_t*)(ws + WS_WA), scr, r, lane); continue; } r -= I_A;
            if (r < I_B) { p0_transpose_item(w_b, DB, D, (bf16_t*)(ws + WS_WB), scr, r, lane); continue; } r -= I_B;
            p0_transpose_item(w_o, D, D, (bf16_t*)(ws + WS_WO), scr, r, lane);
        }
        for (int m = gw; m < TOK; m += NGW) {
            const int R = m & 255; int tokb, L8; row_map(m >> 8, (R >> 6) & 1, R & 15, tokb, L8); const int t = tokb + (4 * (R >> 7) + ((R >> 4) & 3)) * L8;
            const float* xr = (t < NPT) ? args.in[0] + (size_t)t * D : args.in[1] + (size_t)(t - NPT) * D;
            rms_row<true>(xr, args.in[2], (bf16_t*)(ws + WS_H) + (size_t)m * D, lane); }
        for (int i = bx * 512 + tid; i < 2 * D; i += G * 512) { const float* lbp = (i < D) ? args.in[4] : args.in[5]; const int c = i & (D - 1);
            const float a0 = lbp[c], a1 = lbp[D + c]; ((float*)(ws + (i < D ? WS_LBF : WS_LBB)))[c] = 1.0f / (1.0f + expf(a1 - a0)); }
        for (int i = bx * 512 + tid; i < 1024 * 1024; i += G * 512) { const int r = i >> 10, kk = i & 1023, j = r & 511, po = r >> 9, c = kk & 511, pl = kk >> 9; const float ph = (float)((j * c) & 511) * (1.f / 512.f);
            const float cs = __builtin_amdgcn_cosf(ph), sn = __builtin_amdgcn_sinf(ph); const float vv = (po == pl) ? cs : (po ? -sn : sn);
            ((bf16_t*)(ws + WS_DFTC))[i] = (bf16_t)f2bf(vv * 0.04419417382415922f); }
        for (int i = bx * 512 + tid; i < 1024 * 2048; i += G * 512) { const int kx = i >> 11, kk = i & 2047, lx = kk & 1023, part = kk >> 10; const float ph = (float)((kx * lx) & 1023) * (1.f / 1024.f);
            const float vv = (part ? __builtin_amdgcn_sinf(ph) : __builtin_amdgcn_cosf(ph)) * 0.011048543456039806f; ((bf16_t*)(ws + WS_DFTS))[i] = (bf16_t)f2bf(vv); }
        for (int i = bx * 512 + tid; i < 256 * 512; i += G * 512) { const int kx = i >> 9, kk = i & 511, lx = kk & 255, part = kk >> 8; const float ph = (float)((kx * lx) & 255) * (1.f / 256.f);
            const float vv = (part ? __builtin_amdgcn_sinf(ph) : __builtin_amdgcn_cosf(ph)) * 0.022097086912079608f; ((bf16_t*)(ws + WS_DFTS_S))[i] = (bf16_t)f2bf(vv); }
        }

__global__ void __launch_bounds__(NWAVES * 64, 2) fwd_kernel(Args args) {
    extern __shared__ __attribute__((aligned(16))) unsigned char lds_raw[];
    LAS unsigned char* lds = (LAS unsigned char*)lds_raw;
    volatile LAS unsigned* MISC = (volatile LAS unsigned*)(lds + MISC_OFF);
    const int tid = threadIdx.x, lane = tid & 63, wave = __builtin_amdgcn_readfirstlane(tid >> 6);
    const int G = gridDim.x; const int bx = blockIdx.x; const int vcu = (G % 8 == 0) ? (bx % 8) * (G / 8) + bx / 8 : bx;
    unsigned char* ws = args.ws;
    unsigned* ctl = (unsigned*)(ws + WS_CTL);
    for (int u = tid; u < (LDS_BYTES - LDSCTL_OFF) / 4; u += NWAVES * 64) ((LAS unsigned*)(lds + LDSCTL_OFF))[u] = 0u;
    __syncthreads();
    XcdBarrier bar; bar.bar = ctl + CW_BAR; bar.x = 0; bar.st = nullptr;
    if (MK_N_LAUNCHES == 1) bar = xcd_barrier_post(ctl + CW_BAR, MISC + 8);
    const int lo = args.ph_lo, hi = args.ph_hi;
#define IN(k) (lo <= (k) && (k) < hi)
#define BOTH(k) (IN(k) && IN((k) + 1))
#define RPT(k, ...) do { { __VA_ARGS__ } if constexpr (REP[k] > 1) { __VA_ARGS__ } } while (0);
#define GRID_BAR() do { if (MK_N_LAUNCHES == 1) xcd_barrier(bar); } while (0)
    Ctx cx; cx.ws = ws; cx.xp = args.in[0]; cx.xs = args.in[1]; cx.out = args.out; cx.G = G; cx.c = bx;
    const int gw = vcu * NWAVES + wave, NGW = G * NWAVES;

    if (IN(0)) { RPT(0, p0_body(args, ws, lds, G, bx, tid, lane, wave, gw, NGW);)
        if (BOTH(0)) GRID_BAR();
    }
    if (IN(1)) { RPT(1, ProbG1a P; P.init(cx); pg8::gemm_phase(lds, P);) if (BOTH(1)) GRID_BAR(); }
    if (IN(2)) { gla_phase(lds, ws, args.in[6], vcu, G); if (BOTH(2)) GRID_BAR(); }
    if (IN(3)) { {
        RPT(3, { ProbPlain P; P.init(cx, ws + WS_GA, ws + WS_WA, ws + WS_PA, D, D); pg8::gemm_phase(lds, P); }
        { ProbG1b P; P.init(cx); pg8::gemm_phase(lds, P); })
        }
        if (BOTH(3)) GRID_BAR();
    }
    if (IN(4)) { RPT(4, ProbDft1 P; P.init(cx); pg8::gemm_phase(lds, P);) if (BOTH(4)) GRID_BAR(); }
    if (IN(5)) { RPT(5, { ProbDft2 P; P.init(cx, 0); pg8::gemm_phase(lds, P); } { ProbDft2 P; P.init(cx, 1); pg8::gemm_phase(lds, P); }) if (BOTH(5)) GRID_BAR(); }
    if (IN(6)) { RPT(6, ProbPlain P; P.init(cx, ws + WS_BOUT, ws + WS_WB, ws + WS_PB, D, DB); pg8::gemm_phase(lds, P);) if (BOTH(6)) GRID_BAR(); }
    if (IN(7)) { RPT(7, ProbMerge P; P.init(cx); pg8::gemm_phase(lds, P);) if (BOTH(7)) GRID_BAR(); }
    if (IN(8)) { RPT(8, ProbOut P; P.init(cx); pg8::gemm_phase(lds, P);) if (BOTH(8)) GRID_BAR(); }
    if (IN(9)) { int tz = threadIdx.x; asm volatile("" : "+v"(tz)); const int lane9 = tz & 63, gw9 = vcu * NWAVES + __builtin_amdgcn_readfirstlane(tz >> 6);
        for (int m = gw9; m < TOK; m += NGW) rms_row<false>(args.out + (size_t)m * D, args.in[10], args.out + (size_t)m * D, lane9); }
#undef IN
#undef BOTH
#undef GRID_BAR
}

extern "C" void kernel_launch(void* const* d_in, const int* in_sizes, int n_in, void* d_out, int out_size, void* d_ws, size_t ws_size, hipStream_t stream) {
    static int grid = 0;
    if (grid == 0) {
        if (n_in != 11 || ws_size < WS_END) { fprintf(stderr, "kernel_launch: need 11 inputs and >= %zu bytes of workspace (got %d, %zu)\n", (size_t)WS_END, n_in, ws_size); grid = -1; return; }
        int dev = 0, cus = 0;
        if (hipGetDevice(&dev) != hipSuccess || hipDeviceGetAttribute(&cus, hipDeviceAttributeMultiprocessorCount, dev) != hipSuccess) { grid = -1; return; }
        if (hipFuncSetAttribute((const void*)fwd_kernel, hipFuncAttributeMaxDynamicSharedMemorySize, LDS_BYTES) != hipSuccess) { fprintf(stderr, "kernel_launch: hipFuncSetAttribute failed\n"); grid = -1; return; }
        int per_cu = 0;
        if (hipOccupancyMaxActiveBlocksPerMultiprocessor(&per_cu, (const void*)fwd_kernel, NWAVES * 64, LDS_BYTES) != hipSuccess || per_cu < 1) fprintf(stderr, "kernel_launch: occupancy query reports %d\n", per_cu);
        (void)hipGetLastError();
        grid = cus;
    }
    if (grid < 0) return;
    (void)hipMemsetAsync((char*)d_ws + WS_CTL, 0, CTL_ZERO_BYTES, stream);
    Args a{};
    for (int i = 0; i < 11; ++i) a.in[i] = (const float*)d_in[i];
    a.out = (float*)d_out; a.ws = (unsigned char*)d_ws;
    if (MK_N_LAUNCHES == 1) { a.ph_lo = 0; a.ph_hi = N_PHASES; hipLaunchKernelGGL(fwd_kernel, dim3(grid), dim3(NWAVES * 64), LDS_BYTES, stream, a); }
    else for (int li = 0; li < N_PHASES; ++li) { a.ph_lo = li; a.ph_hi = li + 1; hipLaunchKernelGGL(fwd_kernel, dim3(grid), dim3(NWAVES * 64), LDS_BYTES, stream, a); }
}
```
